# Optimizing an MI355X kernel written in HIP

```python
import jax, jax.numpy as jnp
from jax import lax
import numpy as np

D_MODEL = 1024
BATCH = 32
SEQ = 256
DEPTH = 1
DEC_BATCH = 8
DEC_SEQ = 1024
PAST_LEN = 512

GRID_W = 64
EPS = 1e-6
HG_HEADS = 4
HG_DK = 128
HG_DV = 128
HG_WIDTH = HG_HEADS * HG_DK
HG_CHUNK = 32
N_HEADS = 8
N_KV = 2
HEAD_DIM = 64
Q_WIDTH = N_HEADS * HEAD_DIM
KV_WIDTH = N_KV * HEAD_DIM
ATTN_BLOCK = 128
ROPE_THETA = 10000.0
N_BRANCH = 2
D_FF = 4 * D_MODEL
N_MOD = 6
D_IN = 5 * HG_WIDTH + Q_WIDTH + 2 * KV_WIDTH + N_BRANCH * D_MODEL

kernel_name = "hybrid_hgrn2_gqa_diffusion_step"

F32 = jnp.float32


def _split_points():
    sizes = [HG_WIDTH] * 5 + [Q_WIDTH, KV_WIDTH, KV_WIDTH]
    return [int(v) for v in np.cumsum(sizes)]


def rms_norm(x, w):
    xf = x.astype(F32)
    y = xf * lax.rsqrt(jnp.mean(xf * xf, axis=-1, keepdims=True) + EPS)
    return (y * w.astype(F32)).astype(x.dtype)


def adaln(cond, w_ada, b_ada):
    m = jax.nn.silu(cond.astype(F32)) @ w_ada.astype(F32) + b_ada.astype(F32)
    return jnp.split(m[..., None, :], N_MOD, axis=-1)


def _rope_1d(x, cos, sin):
    x1, x2 = jnp.split(x, 2, axis=-1)
    c = cos[:, None, :]
    s = sin[:, None, :]
    return jnp.concatenate([x1 * c - x2 * s, x1 * s + x2 * c], axis=-1)


def axial_rope(x):
    n_tokens = x.shape[1]
    rows = n_tokens // GRID_W
    row = jnp.repeat(jnp.arange(rows, dtype=F32), GRID_W)
    col = jnp.tile(jnp.arange(GRID_W, dtype=F32), rows)
    axis_dim = HEAD_DIM // 2
    freqs = ROPE_THETA ** (-jnp.arange(0, axis_dim, 2, dtype=F32) / axis_dim)
    ang_r = row[:, None] * freqs
    ang_c = col[:, None] * freqs
    xf = x.astype(F32)
    x_row, x_col = jnp.split(xf, 2, axis=-1)
    out = jnp.concatenate([_rope_1d(x_row, jnp.cos(ang_r), jnp.sin(ang_r)),
                           _rope_1d(x_col, jnp.cos(ang_c), jnp.sin(ang_c))], axis=-1)
    return out.astype(x.dtype)


def block_attention(q, k, v):
    b, lq = q.shape[:2]
    nb = lq // ATTN_BLOCK
    qb = q.astype(F32).reshape(b, nb, ATTN_BLOCK, N_KV, N_HEADS // N_KV, HEAD_DIM)
    qb = jnp.moveaxis(qb, 1, 0)
    kf = k.astype(F32)
    vf = v.astype(F32)
    scale = HEAD_DIM ** -0.5

    def one_block(qi):
        s = jnp.einsum('bqkgd,bskd->bkgqs', qi, kf) * scale
        p = jax.nn.softmax(s, axis=-1)
        return jnp.einsum('bkgqs,bskd->bqkgd', p, vf)

    o = lax.map(one_block, qb)
    return jnp.moveaxis(o, 0, 1).reshape(b, lq, Q_WIDTH)


def hgrn_scan(q, k, v, log_f, s0):
    b, l = q.shape[:2]
    n = l // HG_CHUNK

    def chunks(t):
        return t.astype(F32).reshape(b, n, HG_CHUNK, HG_HEADS, -1).transpose(0, 3, 1, 2, 4)

    q, k, v, log_f = chunks(q), chunks(k), chunks(v), chunks(log_f)
    a = jnp.cumsum(log_f, axis=3)
    a_last = a[:, :, :, -1]
    q_dec = q * jnp.exp(a)
    k_dec = k * jnp.exp(-a)
    mask = jnp.tril(jnp.ones((HG_CHUNK, HG_CHUNK), dtype=bool))
    scores = jnp.where(mask, jnp.einsum('bhnik,bhnjk->bhnij', q_dec, k_dec), 0.0)
    o_intra = jnp.einsum('bhnij,bhnjv->bhniv', scores, v)
    k_end = k * jnp.exp(a_last[:, :, :, None, :] - a)
    kv = jnp.einsum('bhnck,bhncv->bhnkv', k_end, v)
    decay = jnp.exp(a_last)

    def step(s, inp):
        dec, kv_n = inp
        return dec[..., None] * s + kv_n, s

    s_final, s_starts = lax.scan(step, s0.astype(F32),
                                 (jnp.moveaxis(decay, 2, 0), jnp.moveaxis(kv, 2, 0)))
    s_starts = jnp.moveaxis(s_starts, 0, 2)
    o_inter = jnp.einsum('bhnck,bhnkv->bhncv', q_dec, s_starts)
    o = (o_intra + o_inter).transpose(0, 2, 3, 1, 4).reshape(b, l, HG_HEADS, HG_DV)
    return o, s_final


def hgrn_branch(hq, hf_fwd, hf_bwd, hi, hg, lb_fwd, lb_bwd, norm_w, s0_fwd, s0_bwd):
    b, l = hq.shape[:2]

    def heads(t):
        return t.astype(F32).reshape(b, l, HG_HEADS, -1)

    q = heads(hq) * HG_DK ** -0.5
    v = heads(hi)

    def gate(h_f, lb):
        f = lb + (1.0 - lb) * jax.nn.sigmoid(h_f.astype(F32))
        return heads(jnp.log(f)), heads(1.0 - f)

    logf_f, k_f = gate(hf_fwd, lb_fwd)
    logf_b, k_b = gate(hf_bwd, lb_bwd)
    o_f, s_f = hgrn_scan(q, k_f, v, logf_f, s0_fwd)

    def flip(t):
        return jnp.flip(t, axis=1)

    o_b, s_b = hgrn_scan(flip(q), flip(k_b), flip(v), flip(logf_b), s0_bwd)
    o = o_f + flip(o_b)
    o = rms_norm(o, norm_w) * jax.nn.silu(heads(hg))
    return o.reshape(b, l, HG_WIDTH), jnp.stack([s_f, s_b], axis=1)


def token_mixer(h, w_in, q_norm_w, k_norm_w, lb_fwd, lb_bwd, hg_norm_w, w_ho, w_ao, w_out,
                ctx_k, ctx_v, s0_fwd, s0_bwd, latent):
    b, l = h.shape[:2]
    z = h @ w_in
    hq, hf_f, hf_b, hi, hg, aq, ak, av, gl = jnp.split(z, _split_points(), axis=-1)
    q = rms_norm(aq.reshape(b, l, N_HEADS, HEAD_DIM), q_norm_w)
    k = rms_norm(ak.reshape(b, l, N_KV, HEAD_DIM), k_norm_w)
    v = av.reshape(b, l, N_KV, HEAD_DIM)
    if latent:
        q = axial_rope(q)
        k_lat = axial_rope(k)
        k_all = jnp.concatenate([ctx_k.astype(k_lat.dtype), k_lat], axis=1)
        v_all = jnp.concatenate([ctx_v.astype(v.dtype), v], axis=1)
    else:
        k_all, v_all = k, v
    o_a = block_attention(q, k_all, v_all)
    o_h, s_final = hgrn_branch(hq, hf_f, hf_b, hi, hg, lb_fwd, lb_bwd, hg_norm_w, s0_fwd, s0_bwd)
    g = jax.nn.sigmoid(gl.astype(F32)).reshape(b, l, N_BRANCH, D_MODEL)
    merged = g[:, :, 0] * (o_h @ w_ho) + g[:, :, 1] * (o_a @ w_ao)
    return merged @ w_out, k, v, s_final


def trunk_layer(x, mod, norm_mix_w, mix_w, ffn_w, ctx_k, ctx_v, s0_fwd, s0_bwd, latent):
    sh1, sc1, g1, sh2, sc2, g2 = mod
    h = rms_norm(x, norm_mix_w) * (1.0 + sc1) + sh1
    out, k, v, s = token_mixer(h, *mix_w, ctx_k, ctx_v, s0_fwd, s0_bwd, latent)
    x = x + g1 * out
    norm_ffn_w, w_ff1, w_ff2 = ffn_w
    h = rms_norm(x, norm_ffn_w) * (1.0 + sc2) + sh2
    x = x + g2 * (jnp.square(jax.nn.relu(h @ w_ff1)) @ w_ff2)
    return x, k, v, s


def setup_inputs(seed: int = 0) -> dict:
    key = jax.random.key(seed)
    ks = jax.random.split(key, 24)
    nrm = jax.random.normal
    return {
        "x_prompt": nrm(ks[0], (BATCH, SEQ, D_MODEL), F32),
        "x_sample": nrm(ks[1], (DEC_BATCH, DEC_SEQ, D_MODEL), F32),
        "cache_k": nrm(ks[2], (DEC_BATCH, DEPTH, PAST_LEN, N_KV, HEAD_DIM), F32),
        "cache_v": nrm(ks[3], (DEC_BATCH, DEPTH, PAST_LEN, N_KV, HEAD_DIM), F32),
        "state_hgrn": 0.5 * nrm(ks[4], (DEC_BATCH, DEPTH, 2, HG_HEADS, HG_DK, HG_DV), F32),
        "c": nrm(ks[5], (DEC_BATCH, D_MODEL), F32),
        "c_ctx": nrm(ks[6], (D_MODEL,), F32),
        "w_ada": nrm(ks[7], (DEPTH, D_MODEL, N_MOD * D_MODEL), F32) * D_MODEL ** -0.5,
        "b_ada": 0.02 * nrm(ks[8], (DEPTH, N_MOD * D_MODEL), F32),
        "norm_mix_w": 1.0 + 0.05 * nrm(ks[9], (DEPTH, D_MODEL), F32),
        "w_in": nrm(ks[10], (DEPTH, D_MODEL, D_IN), F32) * D_MODEL ** -0.5,
        "q_norm_w": 1.0 + 0.05 * nrm(ks[11], (DEPTH, HEAD_DIM), F32),
        "k_norm_w": 1.0 + 0.05 * nrm(ks[12], (DEPTH, HEAD_DIM), F32),
        "hgrn_lb_logits": 0.1 * nrm(ks[13], (2, DEPTH + 1, HG_WIDTH), F32),
        "hgrn_norm_w": 1.0 + 0.05 * nrm(ks[14], (DEPTH, HG_DV), F32),
        "w_hgrn_out": nrm(ks[15], (DEPTH, HG_WIDTH, D_MODEL), F32) * HG_WIDTH ** -0.5,
        "w_attn_out": nrm(ks[16], (DEPTH, Q_WIDTH, D_MODEL), F32) * Q_WIDTH ** -0.5,
        "w_out": nrm(ks[17], (DEPTH, D_MODEL, D_MODEL), F32) * D_MODEL ** -0.5,
        "norm_ffn_w": 1.0 + 0.05 * nrm(ks[18], (DEPTH, D_MODEL), F32),
        "w_ff1": nrm(ks[19], (DEPTH, D_MODEL, D_FF), F32) * D_MODEL ** -0.5,
        "w_ff2": nrm(ks[20], (DEPTH, D_FF, D_MODEL), F32) * D_FF ** -0.5,
        "final_norm_w": 1.0 + 0.05 * nrm(ks[21], (D_MODEL,), F32),
    }


def reference(x_prompt, x_sample, cache_k, cache_v, state_hgrn, c, c_ctx, w_ada, b_ada,
              norm_mix_w, w_in, q_norm_w, k_norm_w, hgrn_lb_logits, hgrn_norm_w,
              w_hgrn_out, w_attn_out, w_out, norm_ffn_w, w_ff1, w_ff2, final_norm_w):
    lb = jnp.cumsum(jax.nn.softmax(hgrn_lb_logits.astype(F32), axis=1), axis=1)
    xp, xs = x_prompt, x_sample
    zero_state = jnp.zeros((xp.shape[0], HG_HEADS, HG_DK, HG_DV), F32)
    new_k, new_v, new_s = [], [], []
    for l in range(DEPTH):
        mix_w = (w_in[l], q_norm_w[l], k_norm_w[l], lb[0, l], lb[1, l], hgrn_norm_w[l],
                 w_hgrn_out[l], w_attn_out[l], w_out[l])
        ffn_w = (norm_ffn_w[l], w_ff1[l], w_ff2[l])
        mod_p = adaln(c_ctx, w_ada[l], b_ada[l])
        xp, k_ctx, v_ctx, s_ctx = trunk_layer(xp, mod_p, norm_mix_w[l], mix_w, ffn_w,
                                              None, None, zero_state, zero_state, False)
        new_k.append(k_ctx)
        new_v.append(v_ctx)
        new_s.append(s_ctx)
        mod_s = adaln(c, w_ada[l], b_ada[l])
        xs, _, _, _ = trunk_layer(xs, mod_s, norm_mix_w[l], mix_w, ffn_w,
                                  cache_k[:, l], cache_v[:, l],
                                  state_hgrn[:, l, 0], state_hgrn[:, l, 1], True)
    y_prompt = rms_norm(xp, final_norm_w)
    y_sample = rms_norm(xs, final_norm_w)
    new_cache_k = jnp.stack(new_k, axis=1)
    new_cache_v = jnp.stack(new_v, axis=1)
    new_state_hgrn = jnp.stack(new_s, axis=1)
    return (y_prompt, y_sample, new_cache_k, new_cache_v, new_state_hgrn)
```

```cpp
#include <hip/hip_runtime.h>
#include <cstdio>
#include <cstdint>
namespace pg8 {
#define PG8_LAS __attribute__((address_space(3)))
typedef unsigned short bf16_t;
typedef short bf16x8 __attribute__((ext_vector_type(8)));
typedef float f32x4 __attribute__((ext_vector_type(4)));
typedef unsigned u32x4 __attribute__((ext_vector_type(4)));
constexpr int BM = 256, BK = 64, HALF = 128, HTB = HALF * BK * 2  , STAGE_BYTES = 8 * HTB, NXCD = 8, WGM = 8;

__host__ __device__ __forceinline__ int lds_byte(int r, int c) { const int st = (r >> 4) * 2 + (c >> 5), rr = r & 15, cc = c & 31, ob = rr * 64 + cc * 2; return st * 1024 + (ob ^ (((ob >> 9) & 1) << 5)); }
__host__ __device__ __forceinline__ void stage_rc(int b, int& R, int& C) { const int st = b / 1024, sb = b % 1024, swz = sb ^ (((sb >> 9) & 1) << 5); R = (st >> 1) * 16 + swz / 64; C = (st & 1) * 32 + (swz % 64) / 2; }
__host__ __device__ __forceinline__ int perm32(int rho) { const int n = rho >> 4, i = rho & 15; return 8 * (i >> 2) + 4 * n + (i & 3); }

struct Unit { int pm, pn; };
struct Gemm { const bf16_t* A; const bf16_t* Bt; int M, N, K, lda; };

struct StaticOrder {
    int nM, nN, nwg, G, c;
    __host__ __device__ void init(int M, int N, int G_, int c_) { nM = M / BM; nN = N / BM; nwg = nM * nN; G = G_; c = c_; }
    __host__ __device__ bool next(int i, Unit& u) const {
        const long L = (long)i * G + c; if (L >= nwg) return false;
        int wgid = (int)L; { const int q = nwg / NXCD, r = nwg % NXCD, xcd = wgid % NXCD, off = wgid / NXCD; wgid = (xcd < r ? xcd * (q + 1) : r * (q + 1) + (xcd - r) * q) + off; }
        const int nig = WGM * nN, gid = wgid / nig, fm = gid * WGM, gsz = (nM - fm) < WGM ? (nM - fm) : WGM;
        u.pm = fm + ((wgid % nig) % gsz); u.pn = (wgid % nig) / gsz; return true;
    }
    __device__ __forceinline__ void a_ready(const Unit&) const {}
    __device__ __forceinline__ void done(const Unit&) const {}
};
__device__ __forceinline__ unsigned cvt_pk_bf16(float lo, float hi) { unsigned r; asm volatile("v_cvt_pk_bf16_f32 %0, %1, %2" : "=v"(r) : "v"(lo), "v"(hi)); return r; }
__device__ __forceinline__ float bf_lo(unsigned w) { return __uint_as_float(w << 16); }
__device__ __forceinline__ float bf_hi(unsigned w) { return __uint_as_float(w & 0xffff0000u); }
__device__ __forceinline__ float sigm(float x) { return __builtin_amdgcn_rcpf(1.0f + __builtin_amdgcn_exp2f(-1.4426950408889634f * x)); }

struct EpiZ {
    static constexpr bool PERM = true, AFTER_DRAIN = false;
    bf16_t *ZH, *ZA, *ZG;
    __device__ __forceinline__ void operator()(const f32x4 (&acc)[2][2][4][2], const Unit& u, int wr, int wc, int fr, int fq) const {
        const int row0 = u.pm * BM + wr * 64 + fr; bf16_t* base; int ld, colt;
        if (u.pn < 10) { base = ZH; ld = 2560; colt = u.pn * BM; } else if (u.pn < 13) { base = ZA; ld = 768; colt = (u.pn - 10) * BM; } else { base = ZG; ld = 2048; colt = (u.pn - 13) * BM; }
        const int col0 = colt + wc * 32 + 8 * fq;
#pragma unroll
        for (int ai = 0; ai < 2; ++ai)
#pragma unroll
            for (int m = 0; m < 4; ++m) { bf16_t* rowp = base + (size_t)(row0 + ai * HALF + m * 16) * ld + col0;
#pragma unroll
                for (int bj = 0; bj < 2; ++bj) { const f32x4 v0 = acc[ai][bj][m][0], v1 = acc[ai][bj][m][1];
                    u32x4 w; w.x = cvt_pk_bf16(v0[0], v0[1]); w.y = cvt_pk_bf16(v0[2], v0[3]); w.z = cvt_pk_bf16(v1[0], v1[1]); w.w = cvt_pk_bf16(v1[2], v1[3]);
                    *(u32x4*)(rowp + bj * HALF) = w; } }
    }
};
template <bool HAS_ADD> struct EpiGate {
    static constexpr bool PERM = true, AFTER_DRAIN = false;
    const bf16_t* G; int ldg; bf16_t* O; int ldo;
    __device__ __forceinline__ void operator()(const f32x4 (&acc)[2][2][4][2], const Unit& u, int wr, int wc, int fr, int fq) const {
        const int row0 = u.pm * BM + wr * 64 + fr, col0 = u.pn * BM + wc * 32 + 8 * fq;
#pragma unroll
        for (int ai = 0; ai < 2; ++ai)
#pragma unroll
            for (int m = 0; m < 4; ++m) { const size_t row = (size_t)(row0 + ai * HALF + m * 16);
#pragma unroll
                for (int bj = 0; bj < 2; ++bj) { const f32x4 v0 = acc[ai][bj][m][0], v1 = acc[ai][bj][m][1];
                    const u32x4 gw = *(const u32x4*)(G + row * ldg + col0 + bj * HALF);
                    float r0 = v0[0] * sigm(bf_lo(gw.x)), r1 = v0[1] * sigm(bf_hi(gw.x)), r2 = v0[2] * sigm(bf_lo(gw.y)), r3 = v0[3] * sigm(bf_hi(gw.y));
                    float r4 = v1[0] * sigm(bf_lo(gw.z)), r5 = v1[1] * sigm(bf_hi(gw.z)), r6 = v1[2] * sigm(bf_lo(gw.w)), r7 = v1[3] * sigm(bf_hi(gw.w));
                    bf16_t* op = O + row * ldo + col0 + bj * HALF;
                    if (HAS_ADD) { const u32x4 aw = *(const u32x4*)op;
                        r0 += bf_lo(aw.x); r1 += bf_hi(aw.x); r2 += bf_lo(aw.y); r3 += bf_hi(aw.y); r4 += bf_lo(aw.z); r5 += bf_hi(aw.z); r6 += bf_lo(aw.w); r7 += bf_hi(aw.w); }
                    u32x4 w; w.x = cvt_pk_bf16(r0, r1); w.y = cvt_pk_bf16(r2, r3); w.z = cvt_pk_bf16(r4, r5); w.w = cvt_pk_bf16(r6, r7);
                    *(u32x4*)op = w; } }
    }
};
struct EpiResid {
    static constexpr bool PERM = false, AFTER_DRAIN = false;
    const float* base_lo; const float* base_hi; float* out; const float* gate;
    __device__ __forceinline__ void operator()(const f32x4 (&acc)[2][2][4][2], const Unit& u, int wr, int wc, int fr, int fq) const {
        const int col0 = u.pn * BM + wc * 32 + 4 * fq;
        const int req = u.pm < 32 ? 0 : 1 + ((u.pm - 32) >> 2);
        const float* bs = u.pm < 32 ? base_lo : base_hi - (size_t)8192 * 1024;
        f32x4 gv[2][2];
#pragma unroll
        for (int bj = 0; bj < 2; ++bj)
#pragma unroll
            for (int n = 0; n < 2; ++n) gv[bj][n] = *(const f32x4*)(gate + (size_t)req * 6144 + col0 + bj * HALF + n * 16);
#pragma unroll
        for (int ai = 0; ai < 2; ++ai)
#pragma unroll
            for (int m = 0; m < 4; ++m) { const size_t off = (size_t)(u.pm * BM + ai * HALF + wr * 64 + m * 16 + fr) * 1024 + col0;
#pragma unroll
                for (int bj = 0; bj < 2; ++bj)
#pragma unroll
                    for (int n = 0; n < 2; ++n) { const f32x4 b = *(const f32x4*)(bs + off + bj * HALF + n * 16);
                        *(f32x4*)(out + off + bj * HALF + n * 16) = b + gv[bj][n] * acc[ai][bj][m][n]; } }
    }
};
struct EpiRelu2 {
    static constexpr bool PERM = true, AFTER_DRAIN = false;
    bf16_t* O; int ldc;
    __device__ __forceinline__ void operator()(const f32x4 (&acc)[2][2][4][2], const Unit& u, int wr, int wc, int fr, int fq) const {
        const int row0 = u.pm * BM + wr * 64 + fr, col0 = u.pn * BM + wc * 32 + 8 * fq;
#pragma unroll
        for (int ai = 0; ai < 2; ++ai)
#pragma unroll
            for (int m = 0; m < 4; ++m) { bf16_t* rowp = O + (size_t)(row0 + ai * HALF + m * 16) * ldc + col0;
#pragma unroll
                for (int bj = 0; bj < 2; ++bj) { f32x4 v0 = acc[ai][bj][m][0], v1 = acc[ai][bj][m][1];
#pragma unroll
                    for (int e = 0; e < 4; ++e) { const float a = fmaxf(v0[e], 0.f), b = fmaxf(v1[e], 0.f); v0[e] = a * a; v1[e] = b * b; }
                    u32x4 w; w.x = cvt_pk_bf16(v0[0], v0[1]); w.y = cvt_pk_bf16(v0[2], v0[3]); w.z = cvt_pk_bf16(v1[0], v1[1]); w.w = cvt_pk_bf16(v1[2], v1[3]);
                    *(u32x4*)(rowp + bj * HALF) = w; } }
    }
};

template <class Epi, class Sched, bool ALIGN_EPI = false, bool SP2 = false>
__device__ __forceinline__ void gemm_phase(PG8_LAS unsigned char* lds, const Gemm g, const Sched& S, const Epi& E) {
    const int tid = threadIdx.x, wid = __builtin_amdgcn_readfirstlane(tid >> 6), lane = tid & 63, wr = wid >> 2, wc = wid & 3, fr = lane & 15, fq = lane >> 4;
    const int K = g.K, nt = K / BK;
    unsigned voffA[2], voffB[2];
#pragma unroll
    for (int i = 0; i < 2; ++i) { int R, C; stage_rc(tid * 16 + i * 8192, R, C); const int Rb = Epi::PERM ? ((R & ~31) + perm32(R & 31)) : R;
        voffA[i] = (unsigned)(R * g.lda + C) * 2u; voffB[i] = (unsigned)(Rb * K + C) * 2u; }
    const size_t kstep = (size_t)(BK * 2);
    const size_t hsA = (size_t)HALF * g.lda * 2, hsB = (size_t)HALF * K * 2;
    const size_t tsA = 2 * hsA, tsB = 2 * hsB;
    const unsigned ldsw = (unsigned)wid * 1024u;
    const int aoff = lds_byte(wr * 64 + fr, fq * 8), boff = lds_byte(wc * 32 + fr, fq * 8);
#define PG8_SA(b, h) (((b) * 2 + (h)) * HTB)
#define PG8_SB(b, h) ((4 + (b) * 2 + (h)) * HTB)
#define PG8_STAGE(bufoff, gbase, voff) do { _Pragma("unroll") for (int _i = 0; _i < 2; ++_i) \
        __builtin_amdgcn_global_load_lds((const unsigned*)((const char*)(gbase) + (voff)[_i]), (PG8_LAS unsigned*)(lds + (bufoff) + ldsw + _i * 8192), 16, 0, 0); } while (0)
#define PG8_LDA(dst, b, h) do { _Pragma("unroll") for (int m = 0; m < 4; ++m) _Pragma("unroll") for (int k = 0; k < 2; ++k) dst[m][k] = *(const PG8_LAS bf16x8*)(lds + PG8_SA(b, h) + aoff + m * 2048 + k * 1024); } while (0)
#define PG8_LDB(dst, b, h) do { _Pragma("unroll") for (int n = 0; n < 2; ++n) _Pragma("unroll") for (int k = 0; k < 2; ++k) dst[n][k] = *(const PG8_LAS bf16x8*)(lds + PG8_SB(b, h) + boff + n * 2048 + k * 1024); } while (0)
#define PG8_MMA(ai, bj, At, Bt) do { __builtin_amdgcn_s_setprio(1); _Pragma("unroll") for (int m = 0; m < 4; ++m) _Pragma("unroll") for (int n = 0; n < 2; ++n) _Pragma("unroll") for (int k = 0; k < 2; ++k) \
        acc[ai][bj][m][n] = __builtin_amdgcn_mfma_f32_16x16x32_bf16(Bt[n][k], At[m][k], acc[ai][bj][m][n], 0, 0, 0); __builtin_amdgcn_s_setprio(0); } while (0)
#define PG8_WAIT_V(n) asm volatile("s_waitcnt vmcnt(" #n ")" ::: "memory")
#define PG8_WAIT_L(n) asm volatile("s_waitcnt lgkmcnt(" #n ")" ::: "memory")
#define PG8_BAR __builtin_amdgcn_s_barrier()
#define PG8_SCHED __builtin_amdgcn_sched_barrier(0)
    Unit cur, nxt; int ui = 0;
    if (!S.next(0, cur)) return;
    f32x4 acc[2][2][4][2];
#pragma unroll
    for (int a = 0; a < 2; ++a)
#pragma unroll
        for (int b = 0; b < 2; ++b)
#pragma unroll
            for (int m = 0; m < 4; ++m)
#pragma unroll
                for (int n = 0; n < 2; ++n) acc[a][b][m][n] = (f32x4){0.f, 0.f, 0.f, 0.f};
    bf16x8 At[4][2], B0[2][2], B1[2][2];
    const char* cA = (const char*)g.A + (size_t)cur.pm * tsA; const char* cB = (const char*)g.Bt + (size_t)cur.pn * tsB;
    S.a_ready(cur);
    if constexpr (SP2) {
        PG8_STAGE(PG8_SB(0, 0), cB, voffB); PG8_STAGE(PG8_SB(0, 1), cB + hsB, voffB); PG8_STAGE(PG8_SA(0, 0), cA, voffA); PG8_STAGE(PG8_SA(0, 1), cA + hsA, voffA);
        if (wr == 1) PG8_BAR;
        PG8_WAIT_V(2); PG8_BAR;
        PG8_STAGE(PG8_SB(1, 0), cB + kstep, voffB); PG8_STAGE(PG8_SA(1, 0), cA + kstep, voffA); PG8_STAGE(PG8_SB(1, 1), cB + hsB + kstep, voffB);
        PG8_WAIT_V(6); PG8_BAR;
    } else {
        PG8_STAGE(PG8_SB(0, 0), cB, voffB); PG8_STAGE(PG8_SA(0, 0), cA, voffA); PG8_STAGE(PG8_SB(0, 1), cB + hsB, voffB); PG8_STAGE(PG8_SA(0, 1), cA + hsA, voffA);
        if (wr == 1) PG8_BAR;
        PG8_WAIT_V(4); PG8_BAR;
        PG8_STAGE(PG8_SB(1, 0), cB + kstep, voffB); PG8_STAGE(PG8_SA(1, 0), cA + kstep, voffA); PG8_STAGE(PG8_SB(1, 1), cB + hsB + kstep, voffB);
        PG8_WAIT_V(6); PG8_BAR;
    }
    for (;;) {
        const bool has_next = S.next(ui + 1, nxt);
        const char* nA = has_next ? (const char*)g.A + (size_t)nxt.pm * tsA : cA; const char* nB = has_next ? (const char*)g.Bt + (size_t)nxt.pn * tsB : cB;
        for (int t = 0; t < nt; t += 2) {
            const bool last = (t == nt - 2);
            const char* a1 = cA + (size_t)(t + 1) * kstep;
            const char* a2 = last ? nA : cA + (size_t)(t + 2) * kstep; const char* b2 = last ? nB : cB + (size_t)(t + 2) * kstep;
            const char* a3 = a2 + kstep; const char* b3 = b2 + kstep;
            if (last && has_next) S.a_ready(nxt);
            if constexpr (SP2) {
            PG8_LDB(B0, 0, 0); PG8_LDB(B1, 0, 1); PG8_SCHED; PG8_LDA(At, 0, 0); PG8_STAGE(PG8_SA(1, 1), a1 + hsA, voffA);
            PG8_WAIT_V(8); PG8_WAIT_L(0); PG8_BAR; PG8_MMA(0, 0, At, B0); PG8_MMA(0, 1, At, B1); PG8_BAR; PG8_SCHED;
            PG8_LDA(At, 0, 1); PG8_STAGE(PG8_SB(0, 0), b2, voffB); PG8_STAGE(PG8_SB(0, 1), b2 + hsB, voffB); PG8_STAGE(PG8_SA(0, 0), a2, voffA);
            PG8_WAIT_V(8); PG8_WAIT_L(0); PG8_BAR; PG8_MMA(1, 0, At, B0); PG8_MMA(1, 1, At, B1); PG8_BAR; PG8_SCHED;
            PG8_LDB(B0, 1, 0); PG8_LDB(B1, 1, 1); PG8_SCHED; PG8_LDA(At, 1, 0); PG8_STAGE(PG8_SA(0, 1), a2 + hsA, voffA);
            PG8_WAIT_V(8); PG8_WAIT_L(0); PG8_BAR; PG8_MMA(0, 0, At, B0); PG8_MMA(0, 1, At, B1); PG8_BAR; PG8_SCHED;
            PG8_LDA(At, 1, 1); PG8_STAGE(PG8_SB(1, 0), b3, voffB); PG8_STAGE(PG8_SB(1, 1), b3 + hsB, voffB); PG8_STAGE(PG8_SA(1, 0), a3, voffA);
            PG8_WAIT_V(8); PG8_WAIT_L(0); PG8_BAR; PG8_MMA(1, 0, At, B0); PG8_MMA(1, 1, At, B1); PG8_BAR; PG8_SCHED;
            } else {
            PG8_LDB(B0, 0, 0); PG8_SCHED; PG8_LDA(At, 0, 0); PG8_STAGE(PG8_SA(1, 1), a1 + hsA, voffA);
            PG8_WAIT_L(8); PG8_BAR; PG8_WAIT_L(0); PG8_MMA(0, 0, At, B0); PG8_BAR; PG8_SCHED;
            PG8_LDB(B1, 0, 1); PG8_STAGE(PG8_SB(0, 0), b2, voffB);
            PG8_BAR; PG8_WAIT_L(0); PG8_MMA(0, 1, At, B1); PG8_BAR;
            PG8_LDA(At, 0, 1); PG8_STAGE(PG8_SA(0, 0), a2, voffA);
            PG8_BAR; PG8_WAIT_L(0); PG8_MMA(1, 0, At, B0); PG8_BAR; PG8_SCHED;
            PG8_STAGE(PG8_SB(0, 1), b2 + hsB, voffB);
            PG8_WAIT_V(6); PG8_BAR; PG8_MMA(1, 1, At, B1); PG8_BAR;
            PG8_LDB(B0, 1, 0); PG8_SCHED; PG8_LDA(At, 1, 0); PG8_STAGE(PG8_SA(0, 1), a2 + hsA, voffA);
            PG8_WAIT_L(8); PG8_BAR; PG8_WAIT_L(0); PG8_MMA(0, 0, At, B0); PG8_BAR; PG8_SCHED;
            PG8_LDB(B1, 1, 1); PG8_STAGE(PG8_SB(1, 0), b3, voffB);
            PG8_BAR; PG8_WAIT_L(0); PG8_MMA(0, 1, At, B1); PG8_BAR;
            PG8_LDA(At, 1, 1); PG8_STAGE(PG8_SA(1, 0), a3, voffA);
            PG8_BAR; PG8_WAIT_L(0); PG8_MMA(1, 0, At, B0); PG8_BAR; PG8_SCHED;
            PG8_STAGE(PG8_SB(1, 1), b3 + hsB, voffB);
            PG8_WAIT_V(6); PG8_BAR; PG8_MMA(1, 1, At, B1); PG8_BAR;
            }
        }
        if constexpr (ALIGN_EPI) { if (wr == 0) PG8_BAR; }
        if constexpr (!Epi::AFTER_DRAIN) { E(acc, cur, wr, wc, fr, fq); S.done(cur); }
        if (!has_next) break;
#pragma unroll
        for (int a = 0; a < 2; ++a)
#pragma unroll
            for (int b = 0; b < 2; ++b)
#pragma unroll
                for (int m = 0; m < 4; ++m)
#pragma unroll
                    for (int n = 0; n < 2; ++n) acc[a][b][m][n] = (f32x4){0.f, 0.f, 0.f, 0.f};
        cur = nxt; cA = nA; cB = nB; ++ui;
        if constexpr (ALIGN_EPI) { if (wr == 1) PG8_BAR; }
    }
    PG8_WAIT_V(0);
    if constexpr (!ALIGN_EPI) { if (wr == 0) PG8_BAR; }
    PG8_BAR;
    if constexpr (Epi::AFTER_DRAIN) { E.fused(acc, cur, wr, wc, fr, fq, lds, wid, lane); S.done(cur); }
#undef PG8_SA
#undef PG8_SB
#undef PG8_STAGE
#undef PG8_LDA
#undef PG8_LDB
#undef PG8_MMA
#undef PG8_WAIT_V
#undef PG8_WAIT_L
#undef PG8_BAR
#undef PG8_SCHED
}
}
#define PG8_SP2 true
#define PG8_ALIGN true
namespace attn_body {
typedef unsigned short bf16;
__device__ __forceinline__ unsigned f2bf_(float f){unsigned u=__builtin_bit_cast(unsigned,f);return (u+0x7fffu+((u>>16)&1u))>>16;}
using bf16x8=__attribute__((ext_vector_type(8)))short;
using s16x4=__attribute__((ext_vector_type(4)))short;
using f32x16=__attribute__((ext_vector_type(16)))float;
using u32x4=__attribute__((ext_vector_type(4)))unsigned;
constexpr int D=64,QP=768,KP=128;
constexpr int NW=8,QBLK=32,QB=QBLK*NW,KVBLK=64;
__device__ __forceinline__ int crow(int r,int hi){return (r&3)+8*(r>>2)+4*hi;}
#define SBAR() __builtin_amdgcn_sched_barrier(0)
constexpr int NSLOT=3, SLOTB=8192;
constexpr int LDS_K=0, LDS_V=NSLOT*SLOTB, LDS_WS=2*NSLOT*SLOTB, LDS_OST=LDS_WS+NW*64*4, LDS_BYTES=LDS_OST+NW*4096;
constexpr float C2=0.125f*1.4426950408889634f;
__device__ __forceinline__ void glds16(const void*gsrc,unsigned lds_dst){unsigned keep;
  asm volatile("s_mov_b32 %0, m0\n\ts_mov_b32 m0, %2\n\ts_nop 0\n\tglobal_load_lds_dwordx4 %1, off\n\ts_mov_b32 m0, %0":"=&s"(keep):"v"(gsrc),"s"(lds_dst):"memory");}
__device__ __forceinline__ float max3f(float a,float b,float c){float r;asm("v_max3_f32 %0, %1, %2, %3":"=v"(r):"v"(a),"v"(b),"v"(c));return r;}
__device__ __forceinline__ float max2f(float a,float b){float r;asm("v_max_f32_e32 %0, %1, %2":"=v"(r):"v"(a),"v"(b));return r;}
__device__ __forceinline__ float fadd_s(float a,float b){float r;asm("v_add_f32_e32 %0, %1, %2":"=v"(r):"v"(a),"v"(b));return r;}
__device__ __forceinline__ float fsub_s(float a,float b){float r;asm("v_sub_f32_e32 %0, %1, %2":"=v"(r):"v"(a),"v"(b));return r;}
typedef float f32x2_t __attribute__((ext_vector_type(2))); typedef __bf16 bf16x2_t __attribute__((ext_vector_type(2)));
__device__ __forceinline__ unsigned cvtpk_s(float lo,float hi){f32x2_t v={lo,hi};bf16x2_t b=__builtin_convertvector(v,bf16x2_t);return __builtin_bit_cast(unsigned,b);}
#define WAIT_BAR(N) asm volatile("s_waitcnt vmcnt(" #N ") lgkmcnt(0)\n\ts_barrier":::"memory")

__device__ __forceinline__ void qkt(f32x16&p0,f32x16&p1,const char*Kslot,const bf16x8*qr,const f32x16&negm,int r32,int hi){
  const char*kb=Kslot+hi*1024+r32*16;
  #pragma unroll
  for(int d0=0;d0<4;++d0){
    const bf16x8 b0=*reinterpret_cast<const bf16x8*>(kb+d0*2048);
    const bf16x8 b1=*reinterpret_cast<const bf16x8*>(kb+d0*2048+512);
    if(d0==0){p0=__builtin_amdgcn_mfma_f32_32x32x16_bf16(b0,qr[0],negm,0,0,0);p1=__builtin_amdgcn_mfma_f32_32x32x16_bf16(b1,qr[0],negm,0,0,0);}
    else{p0=__builtin_amdgcn_mfma_f32_32x32x16_bf16(b0,qr[d0],p0,0,0,0);p1=__builtin_amdgcn_mfma_f32_32x32x16_bf16(b1,qr[d0],p1,0,0,0);}}
}
typedef __attribute__((address_space(3))) const char* lds_cptr;
typedef short v4i16_t __attribute__((ext_vector_type(4)));
__device__ __forceinline__ void kload8(bf16x8*kf,lds_cptr kp){
  kf[0]=*(const __attribute__((address_space(3))) bf16x8*)(kp);      kf[1]=*(const __attribute__((address_space(3))) bf16x8*)(kp+512);
  kf[2]=*(const __attribute__((address_space(3))) bf16x8*)(kp+2048); kf[3]=*(const __attribute__((address_space(3))) bf16x8*)(kp+2560);
  kf[4]=*(const __attribute__((address_space(3))) bf16x8*)(kp+4096); kf[5]=*(const __attribute__((address_space(3))) bf16x8*)(kp+4608);
  kf[6]=*(const __attribute__((address_space(3))) bf16x8*)(kp+6144); kf[7]=*(const __attribute__((address_space(3))) bf16x8*)(kp+6656);
}
__device__ __forceinline__ void kload2(bf16x8*kf,lds_cptr kp,int j){ kf[2*j]=*(const __attribute__((address_space(3))) bf16x8*)(kp+j*2048); kf[2*j+1]=*(const __attribute__((address_space(3))) bf16x8*)(kp+j*2048+512); }
__device__ __forceinline__ s16x4 vtr(lds_cptr p){ return __builtin_bit_cast(s16x4,__builtin_amdgcn_ds_read_tr16_b64_v4i16((__attribute__((address_space(3))) v4i16_t*)p)); }
__device__ __forceinline__ float rowmax(const f32x16&p0,const f32x16&p1){
  float a=max3f(p0[0],p0[1],p1[0]),b=max3f(p0[2],p0[3],p1[1]);a=max3f(a,p1[2],p1[3]);
  #pragma unroll
  for(int r=4;r<16;r+=4){a=max3f(a,p0[r],p0[r+1]);b=max3f(b,p0[r+2],p0[r+3]);a=max3f(a,p1[r],p1[r+1]);b=max3f(b,p1[r+2],p1[r+3]);}
  const float m=max2f(a,b);
  auto rr=__builtin_amdgcn_permlane32_swap(__float_as_uint(m),__float_as_uint(m),false,false);
  return max2f(__uint_as_float(rr[0]),__uint_as_float(rr[1]));
}
__device__ __forceinline__ void pv(f32x16*o,int vb,bf16x8 pa0,bf16x8 pa1,bf16x8 pa2,bf16x8 pa3){
  #pragma unroll
  for(int d0=0;d0<2;++d0){s16x4 lo[4],hi[4];
    #pragma unroll
    for(int ks=0;ks<4;++ks){
      asm volatile("ds_read_b64_tr_b16 %0,%1 offset:%c2":"=&v"(lo[ks]):"v"(vb),"i"(d0*4096+ks*1024):"memory");
      asm volatile("ds_read_b64_tr_b16 %0,%1 offset:%c2":"=&v"(hi[ks]):"v"(vb),"i"(d0*4096+ks*1024+512):"memory");}
    asm volatile("s_waitcnt lgkmcnt(0)":::"memory");SBAR();
    #define PK(k) (bf16x8){lo[k][0],lo[k][1],lo[k][2],lo[k][3],hi[k][0],hi[k][1],hi[k][2],hi[k][3]}
    o[d0]=__builtin_amdgcn_mfma_f32_32x32x16_bf16(pa0,PK(0),o[d0],0,0,0);
    o[d0]=__builtin_amdgcn_mfma_f32_32x32x16_bf16(pa1,PK(1),o[d0],0,0,0);
    o[d0]=__builtin_amdgcn_mfma_f32_32x32x16_bf16(pa2,PK(2),o[d0],0,0,0);
    o[d0]=__builtin_amdgcn_mfma_f32_32x32x16_bf16(pa3,PK(3),o[d0],0,0,0);
    #undef PK
  }
}

#ifndef ATTN_STORE16
#define ATTN_STORE16(p,v) (*(u32x4*)(p)=(v))
#endif
template<int THRL,int NT> __device__ __forceinline__ void attn_unit(const bf16*Qu,const bf16*__restrict__ Kh,const bf16*__restrict__ Vh,bf16*Ou,char*shm){
  const int tid=threadIdx.x,lane=tid&63,r32=lane&31,hi=lane>>5; const int wid=__builtin_amdgcn_readfirstlane(tid>>6);
  const bf16*Qw=Qu+(long)(wid*QBLK)*QP;
  const unsigned lds0=(unsigned)(uintptr_t)shm;
  float*wsf=(float*)(shm+LDS_WS)+wid*64;
  const bf16*ksrc=Kh+(long)lane*KP+wid*8;
  const bf16*vsrc=Vh+(long)(16*(wid&3)+(lane>>2))*KP+(wid>>2)*32+(lane&3)*8;
  const unsigned kdst=lds0+LDS_K+wid*1024, vdst=lds0+LDS_V+wid*1024;
  #define DMA_K(t,slot) glds16(ksrc+(long)(t)*KVBLK*KP,(unsigned)__builtin_amdgcn_readfirstlane(kdst+(slot)))
  #define DMA_V(t,slot) glds16(vsrc+(long)(t)*KVBLK*KP,(unsigned)__builtin_amdgcn_readfirstlane(vdst+(slot)))
  const int vb0=(int)(lds0+LDS_V)+((lane>>4)&1)*32+(lane&3)*8+(4*hi+((lane&15)>>2))*64;
  const char*Kbase=shm+LDS_K; bf16x8 kf[8];
  const lds_cptr shm3=(lds_cptr)shm; const lds_cptr kp0=shm3+LDS_K+hi*1024+r32*16; const lds_cptr vp0=shm3+LDS_V+((lane>>4)&1)*32+(lane&3)*8+(4*hi+((lane&15)>>2))*64;
  static_assert(NT>=4&&(NT&1)==0,"NT even, >= 4");
  DMA_K(0,0);DMA_V(0,0);DMA_K(1,SLOTB);
  bf16x8 qr[4];
  #pragma unroll
  for(int d0=0;d0<4;++d0)qr[d0]=*reinterpret_cast<const bf16x8*>(&Qw[(long)r32*QP+d0*16+hi*8]);
  float mhat=0.f,l_reg=0.f;f32x16 o[2];o[0]=f32x16{};o[1]=f32x16{};f32x16 negm=f32x16{};asm volatile("":"+v"(negm));
  bool resc=false;
  #define START(P0,P1) do{ const float rm=rowmax(P0,P1); resc=false; \
    { const float dl=rm; mhat=fadd_s(mhat,dl); \
      _Pragma("unroll") for(int r=0;r<16;++r){P0[r]=fsub_s(P0[r],dl);P1[r]=fsub_s(P1[r],dl);} \
      _Pragma("unroll") for(int r=0;r<16;++r)negm[r]=-mhat; asm volatile("":"+v"(negm)); } \
    _Pragma("unroll") for(int r=0;r<16;++r)P0[r]=__builtin_amdgcn_exp2f(P0[r]); }while(0)
  #define RESC() do{ if(resc){ asm volatile("s_waitcnt lgkmcnt(0)":::"memory"); \
      _Pragma("unroll") for(int d_=0;d_<2;++d_) _Pragma("unroll") for(int r=0;r<16;++r)o[d_][r]*=wsf[crow(r,hi)]; } }while(0)
  f32x16 pA0,pA1,pB0,pB1;
  int sl_prev=0,sl_cur=0,sl_next=SLOTB;
  #define ROT() do{sl_prev=sl_cur;sl_cur=sl_next;sl_next=(sl_next==(NSLOT-1)*SLOTB)?0:sl_next+SLOTB;}while(0)
  DMA_K(2,2*SLOTB);
  WAIT_BAR(3);
  qkt(pA0,pA1,Kbase,qr,negm,r32,hi);asm volatile("s_nop 15\n\ts_nop 7":"+v"(pA0),"+v"(pA1));
  START(pA0,pA1);
  _Pragma("unroll") for(int r=0;r<16;++r)pA1[r]=__builtin_amdgcn_exp2f(pA1[r]);
  WAIT_BAR(0);
  DMA_K(3,0);DMA_V(1,SLOTB);
  ROT();
  kload8(kf,kp0+sl_cur);
  WAIT_BAR(2);
  s16x4 vlo[8],vhi[8]; u32x4 pw0,pw1,pw2,pw3;
  #define PKW(P,B) cvtpk_s(P[B],P[B+1])
  #define PAF(k) __builtin_bit_cast(bf16x8,pw##k)
  #define VFR(i) (bf16x8){vlo[i][0],vlo[i][1],vlo[i][2],vlo[i][3],vhi[i][0],vhi[i][1],vhi[i][2],vhi[i][3]}
  #define PIN(x) asm volatile("":"+v"(x))
  #define MX3(a,b,c) __builtin_fmaxf(__builtin_fmaxf((a),(b)),(c))
  #define GAPA(MF,A0,A1,A2,A3,W0,W1,PW) do{ MF; sacc+=A0; sacc+=A1; sacc+=A2; sacc+=A3; PIN(sacc); W0; W1; PIN(PW); SBAR(); }while(0)
  #define EX(v) __builtin_amdgcn_exp2f(v)
  #define GAPB(MF,X,B) do{ MF; X[B]=EX(X[B]); X[B+1]=EX(X[B+1]); X[B+2]=EX(X[B+2]); X[B+3]=EX(X[B+3]); PIN(X); SBAR(); }while(0)
  #define VRD(i) do{ vlo[i]=vtr(vp_+(((i)>>2)*4096+((i)&3)*1024)); vhi[i]=vtr(vp_+(((i)>>2)*4096+((i)&3)*1024+512)); }while(0)
  #define KRD(G,j) do{ if(G){ kload2(kf,kp0+sl_next,j); SBAR(); } }while(0)
  #define STEP(C0,C1,P0,P1,t,GK,GV,GL) do{ SBAR(); \
    const lds_cptr vp_=vp0+sl_prev; \
    VRD(0); SBAR(); float sacc=(P0[0]+P0[1]); \
    GAPA(C0=__builtin_amdgcn_mfma_f32_32x32x16_bf16(kf[0],qr[0],negm,0,0,0), P0[2],P0[3],P0[4],P0[5],     pw0[0]=PKW(P0,0), pw0[1]=PKW(P0,2), pw0); \
    VRD(4); SBAR(); GAPA(C1=__builtin_amdgcn_mfma_f32_32x32x16_bf16(kf[1],qr[0],negm,0,0,0), P0[6],P0[7],P0[8],P0[9],     pw0[2]=PKW(P0,4), pw0[3]=PKW(P0,6), pw0); \
    VRD(1); SBAR(); GAPA(C0=__builtin_amdgcn_mfma_f32_32x32x16_bf16(kf[2],qr[1],C0,0,0,0),   P0[10],P0[11],P0[12],P0[13], pw1[0]=PKW(P0,8), pw1[1]=PKW(P0,10), pw1); \
    VRD(5); SBAR(); GAPA(C1=__builtin_amdgcn_mfma_f32_32x32x16_bf16(kf[3],qr[1],C1,0,0,0),   P0[14],P0[15],P1[0],P1[1],   pw1[2]=PKW(P0,12),pw1[3]=PKW(P0,14), pw1); \
    VRD(2); SBAR(); GAPA(C0=__builtin_amdgcn_mfma_f32_32x32x16_bf16(kf[4],qr[2],C0,0,0,0),   P1[2],P1[3],P1[4],P1[5],     pw2[0]=PKW(P1,0), pw2[1]=PKW(P1,2), pw2); \
    VRD(6); SBAR(); GAPA(C1=__builtin_amdgcn_mfma_f32_32x32x16_bf16(kf[5],qr[2],C1,0,0,0),   P1[6],P1[7],P1[8],P1[9],     pw2[2]=PKW(P1,4), pw2[3]=PKW(P1,6), pw2); \
    VRD(3); SBAR(); GAPA(C0=__builtin_amdgcn_mfma_f32_32x32x16_bf16(kf[6],qr[3],C0,0,0,0),   P1[10],P1[11],P1[12],P1[13], pw3[0]=PKW(P1,8), pw3[1]=PKW(P1,10), pw3); \
    VRD(7); SBAR(); GAPA(C1=__builtin_amdgcn_mfma_f32_32x32x16_bf16(kf[7],qr[3],C1,0,0,0),   P1[14],P1[15],0.f,0.f,       pw3[2]=PKW(P1,12),pw3[3]=PKW(P1,14), pw3); \
    l_reg+=sacc; \
    if(GK){DMA_K((t)+3,sl_cur);} if(GV){DMA_V((t)+1,sl_next);} \
    { float a=MX3(C0[0],C0[1],C1[0]),b=MX3(C0[2],C0[3],C1[1]); a=MX3(a,C1[2],C1[3]); \
      _Pragma("unroll") for(int r=4;r<16;r+=4){a=MX3(a,C0[r],C0[r+1]);b=MX3(b,C0[r+2],C0[r+3]);a=MX3(a,C1[r],C1[r+1]);b=MX3(b,C1[r+2],C1[r+3]);} \
      float rm=__builtin_fmaxf(a,b); { auto rr=__builtin_amdgcn_permlane32_swap(__float_as_uint(rm),__float_as_uint(rm),false,false); rm=__builtin_fmaxf(__uint_as_float(rr[0]),__uint_as_float(rr[1])); } \
      resc=false; \
      if(__builtin_expect(__any(rm>(float)THRL),0)){ const float dl=__builtin_fmaxf(rm,0.f); mhat+=dl; \
        _Pragma("unroll") for(int r=0;r<16;++r){C0[r]-=dl;C1[r]-=dl;} \
        _Pragma("unroll") for(int r=0;r<16;++r)negm[r]=-mhat; asm volatile("":"+v"(negm)); \
        const float f=__builtin_amdgcn_exp2f(-dl); l_reg*=f; if(hi==0)wsf[r32]=f; resc=true; } } \
    SBAR(); \
    GAPB(o[0]=__builtin_amdgcn_mfma_f32_32x32x16_bf16(PAF(0),VFR(0),o[0],0,0,0), C0,0); \
    GAPB(o[1]=__builtin_amdgcn_mfma_f32_32x32x16_bf16(PAF(0),VFR(4),o[1],0,0,0), C0,4); \
    KRD(GL,0); GAPB(o[0]=__builtin_amdgcn_mfma_f32_32x32x16_bf16(PAF(1),VFR(1),o[0],0,0,0), C0,8); \
    KRD(GL,1); GAPB(o[1]=__builtin_amdgcn_mfma_f32_32x32x16_bf16(PAF(1),VFR(5),o[1],0,0,0), C0,12); \
    KRD(GL,2); GAPB(o[0]=__builtin_amdgcn_mfma_f32_32x32x16_bf16(PAF(2),VFR(2),o[0],0,0,0), C1,0); \
    KRD(GL,3); GAPB(o[1]=__builtin_amdgcn_mfma_f32_32x32x16_bf16(PAF(2),VFR(6),o[1],0,0,0), C1,4); \
    GAPB(o[0]=__builtin_amdgcn_mfma_f32_32x32x16_bf16(PAF(3),VFR(3),o[0],0,0,0), C1,8); \
    GAPB(o[1]=__builtin_amdgcn_mfma_f32_32x32x16_bf16(PAF(3),VFR(7),o[1],0,0,0), C1,12); \
    }while(0)
  int t=1;
  for(;t+5<NT;t+=2){
    STEP(pB0,pB1,pA0,pA1,t,true,true,true);     WAIT_BAR(2); RESC(); ROT();
    STEP(pA0,pA1,pB0,pB1,t+1,true,true,true);   WAIT_BAR(2); RESC(); ROT();
  }
  #define ENDW(tt) do{ if((tt)+3<NT){WAIT_BAR(2);} else if((tt)+2<NT){WAIT_BAR(1);} else {WAIT_BAR(0);} }while(0)
  for(;t+1<NT;t+=2){
    STEP(pB0,pB1,pA0,pA1,t,(t+3<NT),(t+1<NT),(t+1<NT));       ENDW(t);   RESC(); ROT();
    STEP(pA0,pA1,pB0,pB1,t+1,(t+4<NT),(t+2<NT),(t+2<NT));     ENDW(t+1); RESC(); ROT();
  }
  STEP(pB0,pB1,pA0,pA1,NT-1,false,false,false); RESC();
  { float sacc=pB0[0]+pB0[1]; _Pragma("unroll") for(int r=2;r<16;++r)sacc+=pB0[r]; _Pragma("unroll") for(int r=0;r<16;++r)sacc+=pB1[r]; l_reg+=sacc;
    pw0=(u32x4){PKW(pB0,0),PKW(pB0,2),PKW(pB0,4),PKW(pB0,6)};pw1=(u32x4){PKW(pB0,8),PKW(pB0,10),PKW(pB0,12),PKW(pB0,14)};pw2=(u32x4){PKW(pB1,0),PKW(pB1,2),PKW(pB1,4),PKW(pB1,6)};pw3=(u32x4){PKW(pB1,8),PKW(pB1,10),PKW(pB1,12),PKW(pB1,14)};
    SBAR(); pv(o,vb0+sl_cur,PAF(0),PAF(1),PAF(2),PAF(3)); }
  #undef PKW
  #undef PAF
  #undef VFR
  #undef PIN
  #undef MX3
  #undef GAPA
  #undef GAPB
  #undef EX
  #undef VRD
  #undef KRD
  #undef STEP
  #undef ENDW
  {auto rr=__builtin_amdgcn_permlane32_swap(__float_as_uint(l_reg),__float_as_uint(l_reg),false,false);l_reg=__uint_as_float(rr[0])+__uint_as_float(rr[1]);}
  if(hi==0)wsf[32+r32]=l_reg;asm volatile("s_waitcnt lgkmcnt(0)":::"memory");
  float rli[16];
  #pragma unroll
  for(int r=0;r<16;++r)rli[r]=__builtin_amdgcn_rcpf(wsf[32+crow(r,hi)]);
  bf16*Ow=Ou+(long)(wid*QBLK)*QP;
  { bf16*stg=(bf16*)(shm+LDS_OST)+wid*2048;
    #pragma unroll
    for(int r=0;r<16;++r){const int orow=crow(r,hi);
      #pragma unroll
      for(int d0=0;d0<2;++d0)stg[orow*64+d0*32+r32]=(bf16)f2bf_(o[d0][r]*rli[r]);}
    asm volatile("s_waitcnt lgkmcnt(0)":::"memory");
    #pragma unroll
    for(int i=0;i<4;++i){const int row=i*8+(lane>>3),ch=lane&7; const u32x4 v=*(const u32x4*)(stg+row*64+ch*8); ATTN_STORE16(Ow+(long)row*QP+ch*8,v);} }
  asm volatile("s_waitcnt lgkmcnt(0)\n\ts_barrier":::"memory");
  #undef DMA_K
  #undef DMA_V
  #undef START
  #undef RESC
  #undef ROT
}
constexpr int ATTN_LDS_BYTES=LDS_BYTES;
#undef SBAR
#undef WAIT_BAR
}
#define GAS __attribute__((address_space(1)))
#define LAS __attribute__((address_space(3)))
typedef unsigned short bf16;
typedef unsigned v4u __attribute__((ext_vector_type(4)));
typedef float f32x4 __attribute__((ext_vector_type(4)));
typedef short bf16x8 __attribute__((ext_vector_type(8)));
typedef GAS unsigned gu32;
typedef GAS unsigned long long gu64;
#define RLX_AGENT __ATOMIC_RELAXED, __HIP_MEMORY_SCOPE_AGENT
#define LDS_WAIT() asm volatile("s_waitcnt lgkmcnt(0)" ::: "memory")
#define VM_WAIT() asm volatile("s_waitcnt vmcnt(0)" ::: "memory")
__device__ __forceinline__ unsigned long long rt() { return __builtin_amdgcn_s_memrealtime(); }
__device__ __forceinline__ unsigned f2bf(float f) { unsigned u = __builtin_bit_cast(unsigned, f); return (u + 0x7fffu + ((u >> 16) & 1u)) >> 16; }
__device__ __forceinline__ unsigned pk2(float lo, float hi) { return f2bf(lo) | (f2bf(hi) << 16); }

#define XB_TMO      128
#define XB_XCNT(j)  (256  + 64 * (j))
#define XB_XSUB(j)  (1280 + 64 * (j))
#define XB_XGEN(j)  (2304 + 64 * (j))
#define XB_TOP      3328
#define XB_TOPGEN   3392
#define XCD_BAR_WORDS 3456
#define XB_SPIN_CAP (1u << 18)

__device__ __forceinline__ unsigned xb_ld(unsigned* p)              { return __hip_atomic_load(p, __ATOMIC_RELAXED, __HIP_MEMORY_SCOPE_AGENT); }
__device__ __forceinline__ unsigned xb_add(unsigned* p, unsigned v) { return __hip_atomic_fetch_add(p, v, __ATOMIC_RELAXED, __HIP_MEMORY_SCOPE_AGENT); }
__device__ __forceinline__ unsigned xb_xcc_id() { return (unsigned)__builtin_amdgcn_s_getreg((3 << 11) | 20) & 0xFu; }
#define XB_SPIN(cond, bar) do { unsigned _sp = 0; while (cond) { __builtin_amdgcn_s_sleep(1); \
    if ((++_sp & 255u) == 0u) { if (xb_ld(&(bar)[XB_TMO])) break; if (_sp > XB_SPIN_CAP) { atomicAdd(&(bar)[XB_TMO], 1u); break; } } } } while (0)

struct XcdBarrier {
    unsigned* bar; unsigned x;
    volatile LAS unsigned* st;
};

__device__ __forceinline__ XcdBarrier xcd_barrier_post(unsigned* bar, volatile LAS unsigned* st) {
    XcdBarrier b; b.bar = bar; b.x = xb_xcc_id(); b.st = st;
    if (threadIdx.x == 0) (void)xb_add(&bar[XB_XCNT(b.x)], 1u);
    return b;
}
__device__ __forceinline__ void xcd_barrier_complete(unsigned* bar, unsigned x, unsigned& nloc, unsigned& nx) {
    const unsigned G = gridDim.x * gridDim.y * gridDim.z;
    unsigned sum, cnt, mine, sp = 0u;
    for (;;) {
        sum = 0u; cnt = 0u; mine = 0u;
#pragma unroll
        for (unsigned j = 0; j < 16; ++j) { const unsigned c = xb_ld(&bar[XB_XCNT(j)]); sum += c; cnt += (c > 0u) ? 1u : 0u; mine = (j == x) ? c : mine; }
        if (sum == G) break;
        __builtin_amdgcn_s_sleep(1);
        if ((++sp & 255u) == 0u) { if (xb_ld(&bar[XB_TMO])) break; if (sp > XB_SPIN_CAP) { atomicAdd(&bar[XB_TMO], 1u); break; } }
    }
    nloc = mine > 0u ? mine : 1u; nx = cnt > 0u ? cnt : 1u;
}

__device__ __forceinline__ void xcd_barrier(const XcdBarrier& b) {
    asm volatile("s_waitcnt vmcnt(0)" ::: "memory");
    __syncthreads();
    if (threadIdx.x == 0) {
        unsigned* bar = b.bar;
        __builtin_amdgcn_s_waitcnt(0);
        unsigned nloc = b.st[0], nx = b.st[1];
        if (nloc == 0u) { xcd_barrier_complete(bar, b.x, nloc, nx); b.st[0] = nloc; b.st[1] = nx; }
        const unsigned old = xb_add(&bar[XB_XSUB(b.x)], 1u);
        const unsigned gen = old / nloc;
        if (old + 1u == (gen + 1u) * nloc) {
            __builtin_amdgcn_fence(__ATOMIC_RELEASE, "agent");
            asm volatile("s_waitcnt vmcnt(0)" ::: "memory");
            const unsigned og = xb_add(&bar[XB_TOP], 1u);
            const unsigned tg = og / nx;
            if (og + 1u == (tg + 1u) * nx) xb_add(&bar[XB_TOPGEN], 1u);
            else XB_SPIN(xb_ld(&bar[XB_TOPGEN]) == tg, bar);
            __builtin_amdgcn_fence(__ATOMIC_ACQUIRE, "agent");
            xb_add(&bar[XB_XGEN(b.x)], 1u);
            asm volatile("s_waitcnt vmcnt(0)" ::: "memory");
        } else {
            XB_SPIN(xb_ld(&bar[XB_XGEN(b.x)]) == gen, bar);
            __builtin_amdgcn_fence(__ATOMIC_ACQUIRE, "agent");
            asm volatile("s_waitcnt vmcnt(0)" ::: "memory");
        }
    }
    __syncthreads();
}
__device__ __forceinline__ float wave_sum(float v) {
#pragma unroll
    for (int o = 1; o < 64; o <<= 1) v += __shfl_xor(v, o);
    return v;
}
__device__ __forceinline__ void p0_transpose_item(const float* W, int K, int N, bf16* WT, int row_off, LAS float* scr, int item, int lane) {
    const int nblk = N / 32, kb = item / nblk, nb = item % nblk, k0 = 64 * kb, n0 = 32 * nb;
#pragma unroll 8
    for (int i = 0; i < 32; ++i) { const int kk = 2 * i + (lane >> 5); scr[kk * 33 + (lane & 31)] = W[(size_t)(k0 + kk) * N + n0 + (lane & 31)]; }
    LDS_WAIT(); asm volatile("" ::: "memory");
    const int c = lane & 7;
#pragma unroll
    for (int j = 0; j < 4; ++j) { const int n = (lane >> 3) + 8 * j; const LAS float* s = scr + (8 * c) * 33 + n;
        v4u o; o.x = pk2(s[0 * 33], s[1 * 33]); o.y = pk2(s[2 * 33], s[3 * 33]); o.z = pk2(s[4 * 33], s[5 * 33]); o.w = pk2(s[6 * 33], s[7 * 33]);
        *(GAS v4u*)(WT + (size_t)(row_off + n0 + n) * K + k0 + 8 * c) = o; }
    LDS_WAIT(); asm volatile("" ::: "memory");
}
namespace hg {
typedef short bf16x8 __attribute__((ext_vector_type(8)));
typedef float f32x16 __attribute__((ext_vector_type(16)));
typedef unsigned u32x2 __attribute__((ext_vector_type(2)));
typedef unsigned u32x4 __attribute__((ext_vector_type(4)));
constexpr int ROWB = 272, TROWB = 80;
constexpr int OFF_QD = 0, OFF_KD = 8704, OFF_ST = 17408, OFF_KDT = 52224, OFF_VT = 62464, OFF_SC = 72704, OFF_PL = 93184, OFF_GP = 93696, OFF_OX = 95744, LDS_END = 112128;
__device__ __forceinline__ int crow(int r, int hi) { return (r & 3) + 8 * (r >> 2) + 4 * hi; }
__device__ __forceinline__ unsigned f2bf(float f) { unsigned u = __builtin_bit_cast(unsigned, f); return (u + 0x7fffu + ((u >> 16) & 1u)) >> 16; }
__device__ __forceinline__ float bf2f(unsigned short h) { return __uint_as_float((unsigned)h << 16); }
__device__ __forceinline__ void st_image(LAS unsigned char* lds, const f32x16& S, int cb, int vb, int r, int hh) {
    LAS unsigned char* p = lds + OFF_ST + (32 * vb + r) * ROWB + (32 * cb + 4 * hh) * 2;
#pragma unroll
    for (int q4 = 0; q4 < 4; ++q4) { u32x2 w; w.x = f2bf(S[4 * q4]) | (f2bf(S[4 * q4 + 1]) << 16); w.y = f2bf(S[4 * q4 + 2]) | (f2bf(S[4 * q4 + 3]) << 16); *(LAS u32x2*)(p + 16 * q4) = w; }
}
__device__ __forceinline__ void hgrn_unit(LAS unsigned char* lds, const unsigned short* ZH, float* odir, int row0, int L, int h, int dir, const float* s0, float* sfin, const float* lbl) {
    const int tid = threadIdx.x, lane = tid & 63, wid = __builtin_amdgcn_readfirstlane(tid >> 6), r = lane & 31, hh = lane >> 5;
    const int c = (wid & 1) * 64 + lane, g = wid >> 1;
    const int vb = wid & 3, ch = wid >> 2;
    const float l0 = lbl[dir * 1024 + h * 128 + c], l1 = lbl[dir * 1024 + 512 + h * 128 + c];
    const float lb = 1.0f / (1.0f + __expf(l1 - l0)), oml = 1.0f - lb;
    LAS unsigned short* QD = (LAS unsigned short*)(lds + OFF_QD); LAS unsigned short* KD = (LAS unsigned short*)(lds + OFF_KD);
    LAS float* PL = (LAS float*)(lds + OFF_PL); LAS float* GP = (LAS float*)(lds + OFF_GP); LAS float* OX = (LAS float*)(lds + OFF_OX);
    LAS unsigned short* SCw = (LAS unsigned short*)(lds + OFF_SC + wid * 2560);
    f32x16 S0, S1;
#pragma unroll
    for (int q = 0; q < 16; ++q) {
        if (s0) { S0[q] = s0[(size_t)(64 * ch + crow(q, hh)) * 128 + 32 * vb + r]; S1[q] = s0[(size_t)(64 * ch + 32 + crow(q, hh)) * 128 + 32 * vb + r]; }
        else { S0[q] = 0.f; S1[q] = 0.f; }
    }
    st_image(lds, S0, 2 * ch, vb, r, hh); st_image(lds, S1, 2 * ch + 1, vb, r, hh);
    const int nch = L >> 5;
    const unsigned short* zq = ZH + (size_t)row0 * 2560 + h * 128 + c;
    const int foff = 512 + dir * 512;
    unsigned short rq[8], rf[8], rv[8];
#define HG_LOAD(n) do { _Pragma("unroll") for (int e = 0; e < 8; ++e) { const int p_ = 32 * (n) + 8 * g + e; const int t_ = dir ? (L - 1 - p_) : p_; const unsigned short* zp = zq + (size_t)t_ * 2560; \
        rq[e] = zp[0]; rf[e] = zp[foff]; rv[e] = zp[1536]; } } while (0)
#define HG_OSTORE(n) do { _Pragma("unroll") for (int q = 0; q < 16; ++q) { const int i_ = crow(q, hh); const int p_ = 32 * (n) + i_; const int t_ = dir ? (L - 1 - p_) : p_; \
        odir[(size_t)dir * 8388608 + (size_t)(row0 + t_) * 512 + h * 128 + 32 * vb + r] = o[q] + OX[(vb * 32 + i_) * 32 + r]; } } while (0)
    HG_LOAD(0);
    f32x16 o;
#pragma unroll
    for (int q = 0; q < 16; ++q) o[q] = 0.f;
    for (int n = 0; n < nch; ++n) {
        float qf[8], kk[8], pp[8]; u32x4 vv;
        float p = 1.f;
#pragma unroll
        for (int e = 0; e < 8; ++e) { const float x = bf2f(rf[e]); const float ex = __builtin_amdgcn_exp2f(-1.4426950408889634f * x); const float sg = __builtin_amdgcn_rcpf(1.0f + ex);
            const float f = lb + oml * sg; kk[e] = oml * (1.0f - sg); p *= f; pp[e] = p; qf[e] = bf2f(rq[e]) * 0.08838834764831845f; }
        vv.x = (unsigned)rv[0] | ((unsigned)rv[1] << 16); vv.y = (unsigned)rv[2] | ((unsigned)rv[3] << 16); vv.z = (unsigned)rv[4] | ((unsigned)rv[5] << 16); vv.w = (unsigned)rv[6] | ((unsigned)rv[7] << 16);
        GP[g * 128 + c] = p;
        if (n + 1 < nch) HG_LOAD(n + 1);
        __syncthreads();
        float pre = 1.f, pl = 1.f;
#pragma unroll
        for (int g2 = 0; g2 < 4; ++g2) { const float gv = GP[g2 * 128 + c]; pl *= gv; if (g2 < g) pre *= gv; }
        u32x4 kp; unsigned kb[8];
#pragma unroll
        for (int e = 0; e < 8; ++e) { const float Pi = pre * pp[e]; const int i = 8 * g + e; const float qd = qf[e] * Pi, kd = kk[e] * __builtin_amdgcn_rcpf(Pi);
            kb[e] = f2bf(kd); QD[i * (ROWB / 2) + c] = (unsigned short)f2bf(qd); KD[i * (ROWB / 2) + c] = (unsigned short)kb[e]; }
        kp.x = kb[0] | (kb[1] << 16); kp.y = kb[2] | (kb[3] << 16); kp.z = kb[4] | (kb[5] << 16); kp.w = kb[6] | (kb[7] << 16);
        *(LAS u32x4*)(lds + OFF_KDT + c * TROWB + 16 * g) = kp;
        *(LAS u32x4*)(lds + OFF_VT + c * TROWB + 16 * g) = vv;
        if (g == 0) PL[c] = pl;
        if (n > 0 && ch == 0) HG_OSTORE(n - 1);
        __syncthreads();
        const LAS unsigned char* qdp = lds + OFF_QD + r * ROWB + (64 * ch + 8 * hh) * 2;
        const LAS unsigned char* kdp = lds + OFF_KD + r * ROWB + (64 * ch + 8 * hh) * 2;
        f32x16 sc;
#pragma unroll
        for (int q = 0; q < 16; ++q) sc[q] = 0.f;
#pragma unroll
        for (int s = 0; s < 4; ++s) sc = __builtin_amdgcn_mfma_f32_32x32x16_bf16(*(const LAS bf16x8*)(qdp + 32 * s), *(const LAS bf16x8*)(kdp + 32 * s), sc, 0, 0, 0);
#pragma unroll
        for (int q = 0; q < 16; ++q) { const int i = crow(q, hh); SCw[i * (TROWB / 2) + r] = (unsigned short)f2bf(r <= i ? sc[q] : 0.f); }
        asm volatile("s_waitcnt lgkmcnt(0)" ::: "memory");
        const LAS unsigned char* scp = (const LAS unsigned char*)SCw + r * TROWB + 16 * hh;
        const LAS unsigned char* vtp = lds + OFF_VT + (32 * vb + r) * TROWB + 16 * hh;
        const LAS unsigned char* stp = lds + OFF_ST + (32 * vb + r) * ROWB + (64 * ch + 8 * hh) * 2;
        bf16x8 vf0 = *(const LAS bf16x8*)(vtp), vf1 = *(const LAS bf16x8*)(vtp + 32);
#pragma unroll
        for (int q = 0; q < 16; ++q) o[q] = 0.f;
        o = __builtin_amdgcn_mfma_f32_32x32x16_bf16(*(const LAS bf16x8*)(scp), vf0, o, 0, 0, 0);
        o = __builtin_amdgcn_mfma_f32_32x32x16_bf16(*(const LAS bf16x8*)(scp + 32), vf1, o, 0, 0, 0);
#pragma unroll
        for (int s = 0; s < 4; ++s) o = __builtin_amdgcn_mfma_f32_32x32x16_bf16(*(const LAS bf16x8*)(qdp + 32 * s), *(const LAS bf16x8*)(stp + 32 * s), o, 0, 0, 0);
        {   const LAS unsigned char* k0p = lds + OFF_KDT + (64 * ch + r) * TROWB + 16 * hh;
            const LAS unsigned char* k1p = k0p + 32 * TROWB;
            S0 = __builtin_amdgcn_mfma_f32_32x32x16_bf16(*(const LAS bf16x8*)(k0p), vf0, S0, 0, 0, 0);
            S0 = __builtin_amdgcn_mfma_f32_32x32x16_bf16(*(const LAS bf16x8*)(k0p + 32), vf1, S0, 0, 0, 0);
            S1 = __builtin_amdgcn_mfma_f32_32x32x16_bf16(*(const LAS bf16x8*)(k1p), vf0, S1, 0, 0, 0);
            S1 = __builtin_amdgcn_mfma_f32_32x32x16_bf16(*(const LAS bf16x8*)(k1p + 32), vf1, S1, 0, 0, 0);
#pragma unroll
            for (int q = 0; q < 16; ++q) { S0[q] *= PL[64 * ch + crow(q, hh)]; S1[q] *= PL[64 * ch + 32 + crow(q, hh)]; }
        }
        __syncthreads();
        st_image(lds, S0, 2 * ch, vb, r, hh); st_image(lds, S1, 2 * ch + 1, vb, r, hh);
        if (ch == 1) {
#pragma unroll
            for (int q = 0; q < 16; ++q) OX[(vb * 32 + crow(q, hh)) * 32 + r] = o[q];
        }
    }
    __syncthreads();
    if (ch == 0) HG_OSTORE(nch - 1);
    if (sfin) {
#pragma unroll
        for (int q = 0; q < 16; ++q) { sfin[(size_t)(64 * ch + crow(q, hh)) * 128 + 32 * vb + r] = S0[q]; sfin[(size_t)(64 * ch + 32 + crow(q, hh)) * 128 + 32 * vb + r] = S1[q]; }
    }
    __syncthreads();
#undef HG_LOAD
#undef HG_OSTORE
}
}
constexpr int NWAVES = 8;
#ifndef MK_N_LAUNCHES
#define MK_N_LAUNCHES 1
#endif
constexpr int NPH = 12;
constexpr int N_LAUNCHES = MK_N_LAUNCHES;
constexpr int DMODEL = 1024, MROWS = 16384, MCTX = 8192, NZ = 5376, FFD = 4096;
constexpr int ZH_LD = 2560, ZA_LD = 768, ZG_LD = 2048;
constexpr float EPSN = 1e-6f;
constexpr float ATT_C2 = 0.125f * 1.4426950408889634f;
constexpr size_t OUT_Y = 0, OUT_CK = 16777216, OUT_CV = 17825792, OUT_ST = 18874368, OUT_TOTAL = 23068672;
constexpr size_t MiB = 1u << 20;
constexpr size_t WS_CTL = 0, CTL_ZERO_BYTES = 128 * 1024;
constexpr size_t WS_MOD = 1 * MiB, WS_ROPE = 1 * MiB + 512 * 1024;
constexpr size_t WS_WIN = 2 * MiB, WS_WHO = 13 * MiB, WS_WAO = 14 * MiB, WS_WOUT = 15 * MiB, WS_WF1 = 17 * MiB, WS_WF2 = 25 * MiB;
constexpr size_t WS_KC = 33 * MiB, WS_VC = 35 * MiB, WS_KL = 37 * MiB, WS_VL = 40 * MiB;
constexpr size_t WS_XN = 44 * MiB;
constexpr size_t WS_ZH = 76 * MiB, WS_ZA = 156 * MiB, WS_ZG = 180 * MiB, WS_END = 244 * MiB;
constexpr size_t WS_HB = 76 * MiB;
static_assert(WS_WIN + (size_t)NZ * DMODEL * 2 <= WS_WHO && WS_ZH + (size_t)MROWS * ZH_LD * 2 == WS_ZA && WS_ZA + (size_t)MROWS * ZA_LD * 2 == WS_ZG && WS_ZG + (size_t)MROWS * ZG_LD * 2 == WS_END, "d_ws map");
static_assert(WS_HB + (size_t)MROWS * FFD * 2 <= WS_END && WS_XN + (size_t)MROWS * DMODEL * 2 == WS_ZH && WS_VL + 3 * MiB <= WS_XN, "d_ws map 2");
constexpr int CW_QUEUE = 64;
constexpr int CW_BAR = 4096;
constexpr int RING_OFF = 0, RING_BYTES = 131072;
constexpr int LDSCTL_OFF = RING_BYTES, MISC_OFF = LDSCTL_OFF + 320;
constexpr int LDS_BYTES = 147456;
static_assert(MISC_OFF + 128 <= LDS_BYTES && hg::LDS_END <= RING_BYTES && attn_body::LDS_BYTES <= RING_BYTES, "LDS map");

struct Frame {
    LAS unsigned char* lds;
    volatile LAS unsigned* MISC;
    gu32* ctl;
    int tid, lane, wave;
    int vcu, G;
    const float *x_prompt, *x_sample, *cache_k, *cache_v, *state, *c, *c_ctx, *w_ada, *b_ada, *norm_mix_w, *w_in, *q_norm_w, *k_norm_w, *lb_logits, *hgrn_norm_w, *w_ho, *w_ao, *w_out, *norm_ffn_w, *w_ff1, *w_ff2, *final_w;
    float* out;
    float* MOD; float* ROPE;
    bf16 *WIN, *WHO, *WAO, *WOUT, *WF1, *WF2, *KC, *VC, *KL, *VL, *XN, *ZH, *ZA, *ZG, *HB;
};
__device__ __forceinline__ float bf2f(unsigned short h) { return __uint_as_float((unsigned)h << 16); }
__device__ __forceinline__ float bflo(unsigned w) { return __uint_as_float(w << 16); }
__device__ __forceinline__ float bfhi(unsigned w) { return __uint_as_float(w & 0xffff0000u); }
__device__ __forceinline__ float sigmf(float x) { return __builtin_amdgcn_rcpf(1.0f + __builtin_amdgcn_exp2f(-1.4426950408889634f * x)); }

__device__ __forceinline__ void p0_prologue(Frame& F) {
    {
        LAS float* sil = (LAS float*)(F.lds + RING_OFF);
        LAS float* red = sil + 9 * 1024;
        for (int i = F.tid; i < 9 * 1024; i += NWAVES * 64) { const int r = i >> 10, k = i & 1023; const float x = (r == 0) ? F.c_ctx[k] : F.c[(r - 1) * 1024 + k]; sil[i] = x * sigmf(x); }
        __syncthreads();
        for (int slab = blockIdx.x; slab < 256; slab += F.G) {
            const int n0 = 24 * slab, j = F.tid % 24, ks = F.tid / 24;
            float acc[9];
#pragma unroll
            for (int r = 0; r < 9; ++r) acc[r] = 0.f;
            if (F.tid < 504) {
                for (int k = ks; k < 1024; k += 21) { const float w = F.w_ada[(size_t)k * 6144 + n0 + j];
#pragma unroll
                    for (int r = 0; r < 9; ++r) acc[r] += sil[r * 1024 + k] * w; }
#pragma unroll
                for (int r = 0; r < 9; ++r) red[(ks * 9 + r) * 24 + j] = acc[r];
            }
            __syncthreads();
            if (F.tid < 216) { const int r = F.tid / 24, jj = F.tid % 24; float s = F.b_ada[n0 + jj];
                for (int k2 = 0; k2 < 21; ++k2) s += red[(k2 * 9 + r) * 24 + jj];
                F.MOD[(size_t)r * 6144 + n0 + jj] = s; }
            __syncthreads();
        }
    }
    if (blockIdx.x == 0) {
        for (int i = F.tid; i < 1024; i += NWAVES * 64) { const int pos = i >> 4, fi = i & 15;
            const float freq = __builtin_amdgcn_exp2f(-(float)fi * (13.287712379549449f / 16.0f));
            const float ang = (float)pos * freq; const float nrev = rintf(ang * 0.15915494309189535f);
            float rr = fmaf(-nrev, 6.28125f, ang); rr = fmaf(-nrev, 1.9353071795864769e-3f, rr);
            F.ROPE[2 * i] = __cosf(rr); F.ROPE[2 * i + 1] = __sinf(rr); }
    }
    LAS float* scr = (LAS float*)(F.lds + RING_OFF + F.wave * 16384);
    const int gw = F.vcu * NWAVES + F.wave, NGW = F.G * NWAVES;
    constexpr int I_IN = (1024 / 64) * (NZ / 32), I_HO = (512 / 64) * (1024 / 32), I_AO = I_HO, I_OUT = (1024 / 64) * (1024 / 32), I_F1 = (1024 / 64) * (FFD / 32), I_F2 = (FFD / 64) * (1024 / 32);
    constexpr int NITEMS = I_IN + I_HO + I_AO + I_OUT + I_F1 + I_F2;
    for (int it = gw; it < NITEMS; it += NGW) {
        int r = it;
        if (r < I_IN) { p0_transpose_item(F.w_in, 1024, NZ, F.WIN, 0, scr, r, F.lane); continue; } r -= I_IN;
        if (r < I_HO) { p0_transpose_item(F.w_ho, 512, 1024, F.WHO, 0, scr, r, F.lane); continue; } r -= I_HO;
        if (r < I_AO) { p0_transpose_item(F.w_ao, 512, 1024, F.WAO, 0, scr, r, F.lane); continue; } r -= I_AO;
        if (r < I_OUT) { p0_transpose_item(F.w_out, 1024, 1024, F.WOUT, 0, scr, r, F.lane); continue; } r -= I_OUT;
        if (r < I_F1) { p0_transpose_item(F.w_ff1, 1024, FFD, F.WF1, 0, scr, r, F.lane); continue; } r -= I_F1;
        p0_transpose_item(F.w_ff2, FFD, 1024, F.WF2, 0, scr, r, F.lane);
    }
    for (int i = blockIdx.x * (NWAVES * 64) + F.tid; i < 2 * 65536; i += F.G * NWAVES * 64) {
        const int which = i >> 16, ii = i & 65535, b = ii >> 13, t = (ii >> 4) & 511, chn = ii & 15;
        const float* src = (which ? F.cache_v : F.cache_k) + (size_t)ii * 8;
        const f32x4 a = *(const f32x4*)src, bq = *(const f32x4*)(src + 4);
        v4u o; o.x = pk2(a.x, a.y); o.y = pk2(a.z, a.w); o.z = pk2(bq.x, bq.y); o.w = pk2(bq.z, bq.w);
        *(v4u*)((which ? F.VL : F.KL) + ((size_t)b * 1536 + t) * 128 + chn * 8) = o;
    }
}
__device__ __forceinline__ void norm_mod_rows(Frame& F, const float* src_lo, const float* src_hi, bf16* dst, const float* nw, int sh_off, int sc_off) {
    const int gw = F.vcu * NWAVES + F.wave, NGW = F.G * NWAVES;
    for (int m0 = gw * 8; m0 < MROWS; m0 += NGW * 8) {
        const int req = m0 < MCTX ? 0 : 1 + ((m0 - MCTX) >> 10);
        const float* modr = F.MOD + (size_t)req * 6144;
        f32x4 gvec[4], svec[4];
#pragma unroll
        for (int j = 0; j < 4; ++j) { const int col = 4 * F.lane + 256 * j; const f32x4 w = *(const f32x4*)(nw + col), sc = *(const f32x4*)(modr + sc_off + col); gvec[j] = w * (sc + 1.0f); svec[j] = *(const f32x4*)(modr + sh_off + col); }
        for (int rr = 0; rr < 8; ++rr) { const int m = m0 + rr;
            const float* xrow = m < MCTX ? src_lo + (size_t)m * 1024 : src_hi + (size_t)(m - MCTX) * 1024;
            const f32x4* xr = (const f32x4*)xrow + F.lane;
            f32x4 v[4]; float s = 0.f;
#pragma unroll
            for (int j = 0; j < 4; ++j) { v[j] = xr[64 * j]; s += (v[j].x * v[j].x + v[j].y * v[j].y) + (v[j].z * v[j].z + v[j].w * v[j].w); }
            const float rstd = 1.0f / sqrtf(wave_sum(s) * (1.f / 1024.f) + EPSN);
            unsigned long long* o8 = (unsigned long long*)(dst + (size_t)m * 1024) + F.lane;
#pragma unroll
            for (int j = 0; j < 4; ++j) { const f32x4 y = v[j] * rstd * gvec[j] + svec[j]; o8[64 * j] = (unsigned long long)pk2(y.x, y.y) | ((unsigned long long)pk2(y.z, y.w) << 32); }
        }
    }
}
__device__ __forceinline__ void p3_qk(Frame& F) {
    const int gw = F.vcu * NWAVES + F.wave, NGW = F.G * NWAVES, l = F.lane, sub = l & 7;
    float qw[8], kw[8];
#pragma unroll
    for (int e = 0; e < 8; ++e) { qw[e] = F.q_norm_w[8 * sub + e]; kw[e] = F.k_norm_w[8 * sub + e]; }
    for (int m0 = gw * 8; m0 < MROWS; m0 += NGW * 8) {
        for (int rr = 0; rr < 8; ++rr) { const int row = m0 + rr;
            const bool latent = row >= MCTX; const int t = latent ? ((row - MCTX) & 1023) : (row & 255); const int b = latent ? ((row - MCTX) >> 10) : (row >> 8);
            bf16* zr = F.ZA + (size_t)row * ZA_LD;
            const v4u qraw = *(const v4u*)(zr + 8 * l);
            v4u kvraw = (v4u){0u, 0u, 0u, 0u}; if (l < 32) kvraw = *(const v4u*)(zr + 512 + 8 * l);
            float cs[8], sn[8];
            if (latent) { const int pos = (sub < 4) ? (t >> 6) : (t & 63); const float* tp = F.ROPE + 2 * (pos * 16 + 8 * (sub & 1));
#pragma unroll
                for (int e = 0; e < 8; e += 2) { const f32x4 w = *(const f32x4*)(tp + 2 * e); cs[e] = w.x; sn[e] = w.y; cs[e + 1] = w.z; sn[e + 1] = w.w; } }
            else {
#pragma unroll
                for (int e = 0; e < 8; ++e) { cs[e] = 1.f; sn[e] = 0.f; } }
            float q[8] = {bflo(qraw.x), bfhi(qraw.x), bflo(qraw.y), bfhi(qraw.y), bflo(qraw.z), bfhi(qraw.z), bflo(qraw.w), bfhi(qraw.w)};
            float ss = 0.f;
#pragma unroll
            for (int e = 0; e < 8; ++e) ss += q[e] * q[e];
            ss += __shfl_xor(ss, 1); ss += __shfl_xor(ss, 2); ss += __shfl_xor(ss, 4);
            float rstd = 1.0f / sqrtf(ss * (1.f / 64.f) + EPSN);
#pragma unroll
            for (int e = 0; e < 8; ++e) { q[e] = q[e] * rstd * qw[e]; }
            if (latent) {
#pragma unroll
                for (int e = 0; e < 8; ++e) { const float pr = __shfl_xor(q[e], 2); q[e] = (sub & 2) ? (q[e] * cs[e] + pr * sn[e]) : (q[e] * cs[e] - pr * sn[e]); } }
            { v4u o; o.x = pk2(q[0] * ATT_C2, q[1] * ATT_C2); o.y = pk2(q[2] * ATT_C2, q[3] * ATT_C2); o.z = pk2(q[4] * ATT_C2, q[5] * ATT_C2); o.w = pk2(q[6] * ATT_C2, q[7] * ATT_C2); *(v4u*)(zr + 8 * l) = o; }
            float k[8] = {bflo(kvraw.x), bfhi(kvraw.x), bflo(kvraw.y), bfhi(kvraw.y), bflo(kvraw.z), bfhi(kvraw.z), bflo(kvraw.w), bfhi(kvraw.w)};
            float ks = 0.f;
#pragma unroll
            for (int e = 0; e < 8; ++e) ks += k[e] * k[e];
            ks += __shfl_xor(ks, 1); ks += __shfl_xor(ks, 2); ks += __shfl_xor(ks, 4);
            rstd = 1.0f / sqrtf(ks * (1.f / 64.f) + EPSN);
            float kn[8];
#pragma unroll
            for (int e = 0; e < 8; ++e) kn[e] = k[e] * rstd * kw[e];
            if (!latent) {
                if (l < 16) { float* op = F.out + OUT_CK + (size_t)row * 128 + 8 * l; *(f32x4*)op = (f32x4){kn[0], kn[1], kn[2], kn[3]}; *(f32x4*)(op + 4) = (f32x4){kn[4], kn[5], kn[6], kn[7]}; }
                else if (l < 32) { float* op = F.out + OUT_CV + (size_t)row * 128 + 8 * (l - 16); *(f32x4*)op = (f32x4){k[0], k[1], k[2], k[3]}; *(f32x4*)(op + 4) = (f32x4){k[4], k[5], k[6], k[7]}; }
            } else {
#pragma unroll
                for (int e = 0; e < 8; ++e) { const float pr = __shfl_xor(kn[e], 2); kn[e] = (sub & 2) ? (kn[e] * cs[e] + pr * sn[e]) : (kn[e] * cs[e] - pr * sn[e]); } }
            bf16* kdst = latent ? F.KL + ((size_t)b * 1536 + 512 + t) * 128 : F.KC + (size_t)row * 128;
            bf16* vdst = latent ? F.VL + ((size_t)b * 1536 + 512 + t) * 128 : F.VC + (size_t)row * 128;
            if (l < 16) { v4u o; o.x = pk2(kn[0], kn[1]); o.y = pk2(kn[2], kn[3]); o.z = pk2(kn[4], kn[5]); o.w = pk2(kn[6], kn[7]); *(v4u*)(kdst + 8 * l) = o; }
            else if (l < 32) { *(v4u*)(vdst + 8 * (l - 16)) = kvraw; }
        }
    }
}
__device__ __forceinline__ void p5_combine(Frame& F) {
    const int gw = F.vcu * NWAVES + F.wave, NGW = F.G * NWAVES, l = F.lane;
    float wn[8];
#pragma unroll
    for (int e = 0; e < 8; ++e) wn[e] = F.hgrn_norm_w[8 * (l & 15) + e];
    const float* od0 = F.out + OUT_Y; const float* od1 = od0 + (size_t)MROWS * 512;
    for (int m = gw; m < MROWS; m += NGW) {
        const float* a = od0 + (size_t)m * 512 + 8 * l; const float* bq = od1 + (size_t)m * 512 + 8 * l;
        const f32x4 a0 = *(const f32x4*)a, a1 = *(const f32x4*)(a + 4), b0 = *(const f32x4*)bq, b1 = *(const f32x4*)(bq + 4);
        bf16* zr = F.ZH + (size_t)m * ZH_LD;
        const v4u graw = *(const v4u*)(zr + 2048 + 8 * l);
        float o[8] = {a0.x + b0.x, a0.y + b0.y, a0.z + b0.z, a0.w + b0.w, a1.x + b1.x, a1.y + b1.y, a1.z + b1.z, a1.w + b1.w};
        float ss = 0.f;
#pragma unroll
        for (int e = 0; e < 8; ++e) ss += o[e] * o[e];
        ss += __shfl_xor(ss, 1); ss += __shfl_xor(ss, 2); ss += __shfl_xor(ss, 4); ss += __shfl_xor(ss, 8);
        const float rstd = 1.0f / sqrtf(ss * (1.f / 128.f) + EPSN);
        const float hgv[8] = {bflo(graw.x), bfhi(graw.x), bflo(graw.y), bfhi(graw.y), bflo(graw.z), bfhi(graw.z), bflo(graw.w), bfhi(graw.w)};
        float y[8];
#pragma unroll
        for (int e = 0; e < 8; ++e) y[e] = o[e] * rstd * wn[e] * hgv[e] * sigmf(hgv[e]);
        v4u w; w.x = pk2(y[0], y[1]); w.y = pk2(y[2], y[3]); w.z = pk2(y[4], y[5]); w.w = pk2(y[6], y[7]);
        *(v4u*)(zr + 8 * l) = w;
    }
}
__device__ __forceinline__ void p11_final(Frame& F) {
    const int gw = F.vcu * NWAVES + F.wave, NGW = F.G * NWAVES;
    f32x4 wv[4];
#pragma unroll
    for (int j = 0; j < 4; ++j) wv[j] = *(const f32x4*)(F.final_w + 4 * F.lane + 256 * j);
    for (int m = gw; m < MROWS; m += NGW) {
        f32x4* xr = (f32x4*)(F.out + OUT_Y + (size_t)m * 1024) + F.lane;
        f32x4 v[4]; float s = 0.f;
#pragma unroll
        for (int j = 0; j < 4; ++j) { v[j] = xr[64 * j]; s += (v[j].x * v[j].x + v[j].y * v[j].y) + (v[j].z * v[j].z + v[j].w * v[j].w); }
        const float rstd = 1.0f / sqrtf(wave_sum(s) * (1.f / 1024.f) + EPSN);
#pragma unroll
        for (int j = 0; j < 4; ++j) xr[64 * j] = v[j] * rstd * wv[j];
    }
}
constexpr int MIX_HL = 64, MIX_HC = 256, MIX_H = MIX_HL + MIX_HC, MIX_AL = 256, MIX_AC = 256, MIX_A = MIX_AL + MIX_AC;
__device__ __forceinline__ void p4_hgrn_item(Frame& F, int it) {
    float* odir = F.out + OUT_Y;
    if (it < MIX_HL) { const int b = it >> 3, h = (it >> 1) & 3, dir = it & 1;
        hg::hgrn_unit(F.lds + RING_OFF, F.ZH, odir, MCTX + b * 1024, 1024, h, dir, F.state + (size_t)((b * 2 + dir) * 4 + h) * 16384, nullptr, F.lb_logits);
    } else { const int u = it - MIX_HL, b = u >> 3, h = (u >> 1) & 3, dir = u & 1;
        hg::hgrn_unit(F.lds + RING_OFF, F.ZH, odir, b * 256, 256, h, dir, nullptr, F.out + OUT_ST + (size_t)((b * 2 + dir) * 4 + h) * 16384, F.lb_logits);
    }
}
__device__ __forceinline__ void p4_attn_item(Frame& F, unsigned char* lds_generic, int it) {
    if (it < MIX_AL) { const int u = it, b = u >> 5, head = (u >> 2) & 7, qb = u & 3;
        bf16* q = F.ZA + (size_t)(MCTX + b * 1024 + qb * 256) * ZA_LD + head * 64;
        attn_body::attn_unit<8, 24>(q, F.KL + (size_t)b * 1536 * 128 + (head >> 2) * 64, F.VL + (size_t)b * 1536 * 128 + (head >> 2) * 64, q, (char*)lds_generic + RING_OFF);
    } else { const int u = it - MIX_AL, b = u >> 3, head = u & 7;
        bf16* q = F.ZA + (size_t)(b * 256) * ZA_LD + head * 64;
        attn_body::attn_unit<8, 4>(q, F.KC + (size_t)b * 256 * 128 + (head >> 2) * 64, F.VC + (size_t)b * 256 * 128 + (head >> 2) * 64, q, (char*)lds_generic + RING_OFF);
    }
}
struct Args { const float* in[22]; float* out; unsigned char* ws; int ph_lo, ph_hi; };
__global__ void __launch_bounds__(NWAVES * 64, 2) mk_fwd(Args args) {
    extern __shared__ __attribute__((aligned(16))) unsigned char lds[];
    Frame F;
    F.lds = (LAS unsigned char*)lds;
    F.MISC = (volatile LAS unsigned*)(F.lds + MISC_OFF);
    F.tid = threadIdx.x; F.lane = F.tid & 63; F.wave = __builtin_amdgcn_readfirstlane(F.tid >> 6);
    F.G = gridDim.x; { const int bx = blockIdx.x; F.vcu = (F.G % 8 == 0) ? (bx % 8) * (F.G / 8) + bx / 8 : bx; }
    unsigned char* ws = args.ws;
    F.ctl = (gu32*)(ws + WS_CTL);
    F.x_prompt = args.in[0]; F.x_sample = args.in[1]; F.cache_k = args.in[2]; F.cache_v = args.in[3]; F.state = args.in[4]; F.c = args.in[5]; F.c_ctx = args.in[6];
    F.w_ada = args.in[7]; F.b_ada = args.in[8]; F.norm_mix_w = args.in[9]; F.w_in = args.in[10]; F.q_norm_w = args.in[11]; F.k_norm_w = args.in[12]; F.lb_logits = args.in[13];
    F.hgrn_norm_w = args.in[14]; F.w_ho = args.in[15]; F.w_ao = args.in[16]; F.w_out = args.in[17]; F.norm_ffn_w = args.in[18]; F.w_ff1 = args.in[19]; F.w_ff2 = args.in[20]; F.final_w = args.in[21];
    F.out = args.out;
    F.MOD = (float*)(ws + WS_MOD); F.ROPE = (float*)(ws + WS_ROPE);
    F.WIN = (bf16*)(ws + WS_WIN); F.WHO = (bf16*)(ws + WS_WHO); F.WAO = (bf16*)(ws + WS_WAO); F.WOUT = (bf16*)(ws + WS_WOUT); F.WF1 = (bf16*)(ws + WS_WF1); F.WF2 = (bf16*)(ws + WS_WF2);
    F.KC = (bf16*)(ws + WS_KC); F.VC = (bf16*)(ws + WS_VC); F.KL = (bf16*)(ws + WS_KL); F.VL = (bf16*)(ws + WS_VL);
    F.XN = (bf16*)(ws + WS_XN); F.ZH = (bf16*)(ws + WS_ZH); F.ZA = (bf16*)(ws + WS_ZA); F.ZG = (bf16*)(ws + WS_ZG); F.HB = (bf16*)(ws + WS_HB);
    for (int u = F.tid; u < (LDS_BYTES - LDSCTL_OFF) / 4; u += NWAVES * 64) ((LAS unsigned*)(F.lds + LDSCTL_OFF))[u] = 0u;
    __syncthreads();
    XcdBarrier bar; bar.bar = (unsigned*)(F.ctl + CW_BAR); bar.x = 0; bar.st = nullptr;
    if (N_LAUNCHES == 1) bar = xcd_barrier_post((unsigned*)(F.ctl + CW_BAR), F.MISC + 8);
#define GRID_BAR() do { if (N_LAUNCHES == 1) xcd_barrier(bar); } while (0)
    const int lo = args.ph_lo, hi = args.ph_hi;
#define IN(k) (lo <= (k) && (k) < hi)
#define BOTH(k) (IN(k) && IN((k) + 1))

    if (IN(0)) { p0_prologue(F); if (BOTH(0)) GRID_BAR(); }
    if (IN(1)) { norm_mod_rows(F, F.x_prompt, F.x_sample, F.XN, F.norm_mix_w, 0, 1024); if (BOTH(1)) GRID_BAR(); }
    if (IN(2)) {
        pg8::Gemm g{F.XN, F.WIN, MROWS, NZ, 1024, 1024}; pg8::StaticOrder S; S.init(MROWS, NZ, F.G, (int)blockIdx.x);
        pg8::EpiZ E{F.ZH, F.ZA, F.ZG};
        pg8::gemm_phase<pg8::EpiZ, pg8::StaticOrder, PG8_ALIGN, PG8_SP2>(F.lds + RING_OFF, g, S, E);
        if (BOTH(2)) GRID_BAR();
    }
    if (IN(3)) { p3_qk(F); if (BOTH(3)) GRID_BAR(); }
    if (IN(4)) {
        for (int it = (int)blockIdx.x; it < MIX_H; ) {
            p4_hgrn_item(F, it);
            if (F.tid == 0) F.MISC[4] = (unsigned)F.G + __hip_atomic_fetch_add((unsigned*)(F.ctl + CW_QUEUE), 1u, __ATOMIC_RELAXED, __HIP_MEMORY_SCOPE_AGENT);
            __syncthreads();
            it = (int)F.MISC[4];
            __syncthreads();
        }
        for (;;) {
            if (F.tid == 0) F.MISC[5] = __hip_atomic_fetch_add((unsigned*)(F.ctl + CW_QUEUE + 64), 1u, __ATOMIC_RELAXED, __HIP_MEMORY_SCOPE_AGENT);
            __syncthreads();
            const int it = (int)F.MISC[5];
            __syncthreads();
            if (it >= MIX_A) break;
            p4_attn_item(F, lds, it);
        }
        if (BOTH(4)) GRID_BAR();
    }
    if (IN(5)) {
        p5_combine(F);
        pg8::Gemm g{F.ZA, F.WAO, MROWS, 1024, 512, ZA_LD}; pg8::StaticOrder S; S.init(MROWS, 1024, F.G, (int)blockIdx.x);
        pg8::EpiGate<false> E{F.ZG + 1024, ZG_LD, F.XN, 1024};
        pg8::gemm_phase<pg8::EpiGate<false>, pg8::StaticOrder, PG8_ALIGN, PG8_SP2>(F.lds + RING_OFF, g, S, E);
        if (BOTH(5)) GRID_BAR();
    }
    if (IN(6)) {
        pg8::Gemm g{F.ZH, F.WHO, MROWS, 1024, 512, ZH_LD}; pg8::StaticOrder S; S.init(MROWS, 1024, F.G, (int)blockIdx.x);
        pg8::EpiGate<true> E{F.ZG, ZG_LD, F.XN, 1024};
        pg8::gemm_phase<pg8::EpiGate<true>, pg8::StaticOrder, PG8_ALIGN, PG8_SP2>(F.lds + RING_OFF, g, S, E);
        if (BOTH(6)) GRID_BAR();
    }
    if (IN(7)) {
        pg8::Gemm g{F.XN, F.WOUT, MROWS, 1024, 1024, 1024}; pg8::StaticOrder S; S.init(MROWS, 1024, F.G, (int)blockIdx.x);
        pg8::EpiResid E{F.x_prompt, F.x_sample, F.out + OUT_Y, F.MOD + 2048};
        pg8::gemm_phase<pg8::EpiResid, pg8::StaticOrder, PG8_ALIGN, PG8_SP2>(F.lds + RING_OFF, g, S, E);
        if (BOTH(7)) GRID_BAR();
    }
    if (IN(8)) { norm_mod_rows(F, F.out + OUT_Y, F.out + OUT_Y + (size_t)MCTX * 1024, F.XN, F.norm_ffn_w, 3072, 4096); if (BOTH(8)) GRID_BAR(); }
    if (IN(9)) {
        pg8::Gemm g{F.XN, F.WF1, MROWS, FFD, 1024, 1024}; pg8::StaticOrder S; S.init(MROWS, FFD, F.G, (int)blockIdx.x);
        pg8::EpiRelu2 E{F.HB, FFD};
        pg8::gemm_phase<pg8::EpiRelu2, pg8::StaticOrder, PG8_ALIGN, PG8_SP2>(F.lds + RING_OFF, g, S, E);
        if (BOTH(9)) GRID_BAR();
    }
    if (IN(10)) {
        pg8::Gemm g{F.HB, F.WF2, MROWS, 1024, FFD, FFD}; pg8::StaticOrder S; S.init(MROWS, 1024, F.G, (int)blockIdx.x);
        pg8::EpiResid E{F.out + OUT_Y, F.out + OUT_Y + (size_t)MCTX * 1024, F.out + OUT_Y, F.MOD + 5120};
        pg8::gemm_phase<pg8::EpiResid, pg8::StaticOrder, PG8_ALIGN, PG8_SP2>(F.lds + RING_OFF, g, S, E);
        if (BOTH(10)) GRID_BAR();
    }
    if (IN(11)) { p11_final(F); }
#undef IN
#undef BOTH
#undef GRID_BAR
}

extern "C" void kernel_launch(void* const* d_in, const int* in_sizes, int n_in, void* d_out, int out_size, void* d_ws, size_t ws_size, hipStream_t stream) {
    static int grid = 0;
    if (grid == 0) {
        if (n_in != 22 || out_size != (int)OUT_TOTAL || ws_size < WS_END) { fprintf(stderr, "kernel_launch: unexpected shapes: n_in %d out %d ws %zu; nothing launched\n", n_in, out_size, ws_size); grid = -1; return; }
        int dev = 0, cus = 0, per_cu = 0;
        if (hipGetDevice(&dev) != hipSuccess || hipDeviceGetAttribute(&cus, hipDeviceAttributeMultiprocessorCount, dev) != hipSuccess) { fprintf(stderr, "kernel_launch: device query failed\n"); grid = -1; return; }
        if (hipFuncSetAttribute((const void*)mk_fwd, hipFuncAttributeMaxDynamicSharedMemorySize, LDS_BYTES) != hipSuccess) { fprintf(stderr, "kernel_launch: hipFuncSetAttribute failed\n"); grid = -1; return; }
        if (hipOccupancyMaxActiveBlocksPerMultiprocessor(&per_cu, (const void*)mk_fwd, NWAVES * 64, LDS_BYTES) != hipSuccess || per_cu < 1) { fprintf(stderr, "kernel_launch: occupancy query reports %d workgroups per CU\n", per_cu); (void)hipGetLastError(); grid = -1; return; }
        grid = cus;
        if (grid > 256) grid = 256;
    }
    if (grid < 0) return;
    if (hipMemsetAsync((char*)d_ws + WS_CTL, 0, CTL_ZERO_BYTES, stream) != hipSuccess) { fprintf(stderr, "kernel_launch: hipMemsetAsync failed\n"); return; }
    Args a{};
    for (int i = 0; i < 22; ++i) a.in[i] = (const float*)d_in[i];
    a.out = (float*)d_out; a.ws = (unsigned char*)d_ws;
    for (int li = 0; li < N_LAUNCHES; ++li) {
        a.ph_lo = (N_LAUNCHES == 1) ? 0 : li; a.ph_hi = (N_LAUNCHES == 1) ? NPH : li + 1;
        hipLaunchKernelGGL(mk_fwd, dim3(grid), dim3(NWAVES * 64), LDS_BYTES, stream, a);
        const hipError_t le = hipPeekAtLastError();
        if (le != hipSuccess) { fprintf(stderr, "kernel_launch: launch %d failed: %s\n", li, hipGetErrorName(le)); break; }
    }
}
```

```cpp
#include <hip/hip_runtime.h>
#include <cstdio>
#include <cstdint>
namespace pg8 {
#define PG8_LAS __attribute__((address_space(3)))
typedef unsigned short bf16_t;
typedef short bf16x8 __attribute__((ext_vector_type(8)));
typedef float f32x4 __attribute__((ext_vector_type(4)));
typedef unsigned u32x4 __attribute__((ext_vector_type(4)));
constexpr int BM = 256, BK = 64, HALF = 128, HTB = HALF * BK * 2  , STAGE_BYTES = 8 * HTB, NXCD = 8, WGM = 8;

__host__ __device__ __forceinline__ int lds_byte(int r, int c) { const int st = (r >> 4) * 2 + (c >> 5), rr = r & 15, cc = c & 31, ob = rr * 64 + cc * 2; return st * 1024 + (ob ^ (((ob >> 9) & 1) << 5)); }
__host__ __device__ __forceinline__ void stage_rc(int b, int& R, int& C) { const int st = b / 1024, sb = b % 1024, swz = sb ^ (((sb >> 9) & 1) << 5); R = (st >> 1) * 16 + swz / 64; C = (st & 1) * 32 + (swz % 64) / 2; }
__host__ __device__ __forceinline__ int perm32(int rho) { const int n = rho >> 4, i = rho & 15; return 8 * (i >> 2) + 4 * n + (i & 3); }

struct Unit { int pm, pn; };
struct Gemm { const bf16_t* A; const bf16_t* Bt; int M, N, K, lda; };

struct StaticOrder {
    int nM, nN, nwg, G, c;
    __host__ __device__ void init(int M, int N, int G_, int c_) { nM = M / BM; nN = N / BM; nwg = nM * nN; G = G_; c = c_; }
    __host__ __device__ bool next(int i, Unit& u) const {
        const long L = (long)i * G + c; if (L >= nwg) return false;
        int wgid = (int)L; { const int q = nwg / NXCD, r = nwg % NXCD, xcd = wgid % NXCD, off = wgid / NXCD; wgid = (xcd < r ? xcd * (q + 1) : r * (q + 1) + (xcd - r) * q) + off; }
        const int nig = WGM * nN, gid = wgid / nig, fm = gid * WGM, gsz = (nM - fm) < WGM ? (nM - fm) : WGM;
        u.pm = fm + ((wgid % nig) % gsz); u.pn = (wgid % nig) / gsz; return true;
    }
    __device__ __forceinline__ void a_ready(const Unit&) const {}
    __device__ __forceinline__ void done(const Unit&) const {}
};
__device__ __forceinline__ unsigned cvt_pk_bf16(float lo, float hi) { unsigned r; asm volatile("v_cvt_pk_bf16_f32 %0, %1, %2" : "=v"(r) : "v"(lo), "v"(hi)); return r; }
__device__ __forceinline__ float bf_lo(unsigned w) { return __uint_as_float(w << 16); }
__device__ __forceinline__ float bf_hi(unsigned w) { return __uint_as_float(w & 0xffff0000u); }
__device__ __forceinline__ float sigm(float x) { return __builtin_amdgcn_rcpf(1.0f + __builtin_amdgcn_exp2f(-1.4426950408889634f * x)); }

struct EpiZ {
    static constexpr bool PERM = true, AFTER_DRAIN = false;
    bf16_t *ZH, *ZA, *ZG;
    __device__ __forceinline__ void operator()(const f32x4 (&acc)[2][2][4][2], const Unit& u, int wr, int wc, int fr, int fq) const {
        const int row0 = u.pm * BM + wr * 64 + fr; bf16_t* base; int ld, colt;
        if (u.pn < 10) { base = ZH; ld = 2560; colt = u.pn * BM; } else if (u.pn < 13) { base = ZA; ld = 768; colt = (u.pn - 10) * BM; } else { base = ZG; ld = 2048; colt = (u.pn - 13) * BM; }
        const int col0 = colt + wc * 32 + 8 * fq;
#pragma unroll
        for (int ai = 0; ai < 2; ++ai)
#pragma unroll
            for (int m = 0; m < 4; ++m) { bf16_t* rowp = base + (size_t)(row0 + ai * HALF + m * 16) * ld + col0;
#pragma unroll
                for (int bj = 0; bj < 2; ++bj) { const f32x4 v0 = acc[ai][bj][m][0], v1 = acc[ai][bj][m][1];
                    u32x4 w; w.x = cvt_pk_bf16(v0[0], v0[1]); w.y = cvt_pk_bf16(v0[2], v0[3]); w.z = cvt_pk_bf16(v1[0], v1[1]); w.w = cvt_pk_bf16(v1[2], v1[3]);
                    *(u32x4*)(rowp + bj * HALF) = w; } }
    }
};
template <bool HAS_ADD> struct EpiGate {
    static constexpr bool PERM = true, AFTER_DRAIN = false;
    const bf16_t* G; int ldg; bf16_t* O; int ldo;
    __device__ __forceinline__ void operator()(const f32x4 (&acc)[2][2][4][2], const Unit& u, int wr, int wc, int fr, int fq) const {
        const int row0 = u.pm * BM + wr * 64 + fr, col0 = u.pn * BM + wc * 32 + 8 * fq;
#pragma unroll
        for (int ai = 0; ai < 2; ++ai)
#pragma unroll
            for (int m = 0; m < 4; ++m) { const size_t row = (size_t)(row0 + ai * HALF + m * 16);
#pragma unroll
                for (int bj = 0; bj < 2; ++bj) { const f32x4 v0 = acc[ai][bj][m][0], v1 = acc[ai][bj][m][1];
                    const u32x4 gw = *(const u32x4*)(G + row * ldg + col0 + bj * HALF);
                    float r0 = v0[0] * sigm(bf_lo(gw.x)), r1 = v0[1] * sigm(bf_hi(gw.x)), r2 = v0[2] * sigm(bf_lo(gw.y)), r3 = v0[3] * sigm(bf_hi(gw.y));
                    float r4 = v1[0] * sigm(bf_lo(gw.z)), r5 = v1[1] * sigm(bf_hi(gw.z)), r6 = v1[2] * sigm(bf_lo(gw.w)), r7 = v1[3] * sigm(bf_hi(gw.w));
                    bf16_t* op = O + row * ldo + col0 + bj * HALF;
                    if (HAS_ADD) { const u32x4 aw = *(const u32x4*)op;
                        r0 += bf_lo(aw.x); r1 += bf_hi(aw.x); r2 += bf_lo(aw.y); r3 += bf_hi(aw.y); r4 += bf_lo(aw.z); r5 += bf_hi(aw.z); r6 += bf_lo(aw.w); r7 += bf_hi(aw.w); }
                    u32x4 w; w.x = cvt_pk_bf16(r0, r1); w.y = cvt_pk_bf16(r2, r3); w.z = cvt_pk_bf16(r4, r5); w.w = cvt_pk_bf16(r6, r7);
                    *(u32x4*)op = w; } }
    }
};
struct EpiResid {
    static constexpr bool PERM = false, AFTER_DRAIN = false;
    const float* base_lo; const float* base_hi; float* out; const float* gate;
    __device__ __forceinline__ void operator()(const f32x4 (&acc)[2][2][4][2], const Unit& u, int wr, int wc, int fr, int fq) const {
        const int col0 = u.pn * BM + wc * 32 + 4 * fq;
        const int req = u.pm < 32 ? 0 : 1 + ((u.pm - 32) >> 2);
        const float* bs = u.pm < 32 ? base_lo : base_hi - (size_t)8192 * 1024;
        f32x4 gv[2][2];
#pragma unroll
        for (int bj = 0; bj < 2; ++bj)
#pragma unroll
            for (int n = 0; n < 2; ++n) gv[bj][n] = *(const f32x4*)(gate + (size_t)req * 6144 + col0 + bj * HALF + n * 16);
#pragma unroll
        for (int ai = 0; ai < 2; ++ai)
#pragma unroll
            for (int m = 0; m < 4; ++m) { const size_t off = (size_t)(u.pm * BM + ai * HALF + wr * 64 + m * 16 + fr) * 1024 + col0;
#pragma unroll
                for (int bj = 0; bj < 2; ++bj)
#pragma unroll
                    for (int n = 0; n < 2; ++n) { const f32x4 b = *(const f32x4*)(bs + off + bj * HALF + n * 16);
                        *(f32x4*)(out + off + bj * HALF + n * 16) = b + gv[bj][n] * acc[ai][bj][m][n]; } }
    }
};
struct EpiRelu2 {
    static constexpr bool PERM = true, AFTER_DRAIN = false;
    bf16_t* O; int ldc;
    __device__ __forceinline__ void operator()(const f32x4 (&acc)[2][2][4][2], const Unit& u, int wr, int wc, int fr, int fq) const {
        const int row0 = u.pm * BM + wr * 64 + fr, col0 = u.pn * BM + wc * 32 + 8 * fq;
#pragma unroll
        for (int ai = 0; ai < 2; ++ai)
#pragma unroll
            for (int m = 0; m < 4; ++m) { bf16_t* rowp = O + (size_t)(row0 + ai * HALF + m * 16) * ldc + col0;
#pragma unroll
                for (int bj = 0; bj < 2; ++bj) { f32x4 v0 = acc[ai][bj][m][0], v1 = acc[ai][bj][m][1];
#pragma unroll
                    for (int e = 0; e < 4; ++e) { const float a = fmaxf(v0[e], 0.f), b = fmaxf(v1[e], 0.f); v0[e] = a * a; v1[e] = b * b; }
                    u32x4 w; w.x = cvt_pk_bf16(v0[0], v0[1]); w.y = cvt_pk_bf16(v0[2], v0[3]); w.z = cvt_pk_bf16(v1[0], v1[1]); w.w = cvt_pk_bf16(v1[2], v1[3]);
                    *(u32x4*)(rowp + bj * HALF) = w; } }
    }
};

template <class Epi, class Sched, bool ALIGN_EPI = false, bool SP2 = false>
__device__ __forceinline__ void gemm_phase(PG8_LAS unsigned char* lds, const Gemm g, const Sched& S, const Epi& E) {
    const int tid = threadIdx.x, wid = __builtin_amdgcn_readfirstlane(tid >> 6), lane = tid & 63, wr = wid >> 2, wc = wid & 3, fr = lane & 15, fq = lane >> 4;
    const int K = g.K, nt = K / BK;
    unsigned voffA[2], voffB[2];
#pragma unroll
    for (int i = 0; i < 2; ++i) { int R, C; stage_rc(tid * 16 + i * 8192, R, C); const int Rb = Epi::PERM ? ((R & ~31) + perm32(R & 31)) : R;
        voffA[i] = (unsigned)(R * g.lda + C) * 2u; voffB[i] = (unsigned)(Rb * K + C) * 2u; }
    const size_t kstep = (size_t)(BK * 2);
    const size_t hsA = (size_t)HALF * g.lda * 2, hsB = (size_t)HALF * K * 2;
    const size_t tsA = 2 * hsA, tsB = 2 * hsB;
    const unsigned ldsw = (unsigned)wid * 1024u;
    const int aoff = lds_byte(wr * 64 + fr, fq * 8), boff = lds_byte(wc * 32 + fr, fq * 8);
#define PG8_SA(b, h) (((b) * 2 + (h)) * HTB)
#define PG8_SB(b, h) ((4 + (b) * 2 + (h)) * HTB)
#define PG8_STAGE(bufoff, gbase, voff) do { _Pragma("unroll") for (int _i = 0; _i < 2; ++_i) \
        __builtin_amdgcn_global_load_lds((const unsigned*)((const char*)(gbase) + (voff)[_i]), (PG8_LAS unsigned*)(lds + (bufoff) + ldsw + _i * 8192), 16, 0, 0); } while (0)
#define PG8_LDA(dst, b, h) do { _Pragma("unroll") for (int m = 0; m < 4; ++m) _Pragma("unroll") for (int k = 0; k < 2; ++k) dst[m][k] = *(const PG8_LAS bf16x8*)(lds + PG8_SA(b, h) + aoff + m * 2048 + k * 1024); } while (0)
#define PG8_LDB(dst, b, h) do { _Pragma("unroll") for (int n = 0; n < 2; ++n) _Pragma("unroll") for (int k = 0; k < 2; ++k) dst[n][k] = *(const PG8_LAS bf16x8*)(lds + PG8_SB(b, h) + boff + n * 2048 + k * 1024); } while (0)
#define PG8_MMA(ai, bj, At, Bt) do { __builtin_amdgcn_s_setprio(1); _Pragma("unroll") for (int m = 0; m < 4; ++m) _Pragma("unroll") for (int n = 0; n < 2; ++n) _Pragma("unroll") for (int k = 0; k < 2; ++k) \
        acc[ai][bj][m][n] = __builtin_amdgcn_mfma_f32_16x16x32_bf16(Bt[n][k], At[m][k], acc[ai][bj][m][n], 0, 0, 0); __builtin_amdgcn_s_setprio(0); } while (0)
#define PG8_WAIT_V(n) asm volatile("s_waitcnt vmcnt(" #n ")" ::: "memory")
#define PG8_WAIT_L(n) asm volatile("s_waitcnt lgkmcnt(" #n ")" ::: "memory")
#define PG8_BAR __builtin_amdgcn_s_barrier()
#define PG8_SCHED __builtin_amdgcn_sched_barrier(0)
    Unit cur, nxt; int ui = 0;
    if (!S.next(0, cur)) return;
    f32x4 acc[2][2][4][2];
#pragma unroll
    for (int a = 0; a < 2; ++a)
#pragma unroll
        for (int b = 0; b < 2; ++b)
#pragma unroll
            for (int m = 0; m < 4; ++m)
#pragma unroll
                for (int n = 0; n < 2; ++n) acc[a][b][m][n] = (f32x4){0.f, 0.f, 0.f, 0.f};
    bf16x8 At[4][2], B0[2][2], B1[2][2];
    const char* cA = (const char*)g.A + (size_t)cur.pm * tsA; const char* cB = (const char*)g.Bt + (size_t)cur.pn * tsB;
    S.a_ready(cur);
    if constexpr (SP2) {
        PG8_STAGE(PG8_SB(0, 0), cB, voffB); PG8_STAGE(PG8_SB(0, 1), cB + hsB, voffB); PG8_STAGE(PG8_SA(0, 0), cA, voffA); PG8_STAGE(PG8_SA(0, 1), cA + hsA, voffA);
        if (wr == 1) PG8_BAR;
        PG8_WAIT_V(2); PG8_BAR;
        PG8_STAGE(PG8_SB(1, 0), cB + kstep, voffB); PG8_STAGE(PG8_SA(1, 0), cA + kstep, voffA); PG8_STAGE(PG8_SB(1, 1), cB + hsB + kstep, voffB);
        PG8_WAIT_V(6); PG8_BAR;
    } else {
        PG8_STAGE(PG8_SB(0, 0), cB, voffB); PG8_STAGE(PG8_SA(0, 0), cA, voffA); PG8_STAGE(PG8_SB(0, 1), cB + hsB, voffB); PG8_STAGE(PG8_SA(0, 1), cA + hsA, voffA);
        if (wr == 1) PG8_BAR;
        PG8_WAIT_V(4); PG8_BAR;
        PG8_STAGE(PG8_SB(1, 0), cB + kstep, voffB); PG8_STAGE(PG8_SA(1, 0), cA + kstep, voffA); PG8_STAGE(PG8_SB(1, 1), cB + hsB + kstep, voffB);
        PG8_WAIT_V(6); PG8_BAR;
    }
    for (;;) {
        const bool has_next = S.next(ui + 1, nxt);
        const char* nA = has_next ? (const char*)g.A + (size_t)nxt.pm * tsA : cA; const char* nB = has_next ? (const char*)g.Bt + (size_t)nxt.pn * tsB : cB;
        for (int t = 0; t < nt; t += 2) {
            const bool last = (t == nt - 2);
            const char* a1 = cA + (size_t)(t + 1) * kstep;
            const char* a2 = last ? nA : cA + (size_t)(t + 2) * kstep; const char* b2 = last ? nB : cB + (size_t)(t + 2) * kstep;
            const char* a3 = a2 + kstep; const char* b3 = b2 + kstep;
            if (last && has_next) S.a_ready(nxt);
            if constexpr (SP2) {
            PG8_LDB(B0, 0, 0); PG8_LDB(B1, 0, 1); PG8_SCHED; PG8_LDA(At, 0, 0); PG8_STAGE(PG8_SA(1, 1), a1 + hsA, voffA);
            PG8_WAIT_V(8); PG8_WAIT_L(0); PG8_BAR; PG8_MMA(0, 0, At, B0); PG8_MMA(0, 1, At, B1); PG8_BAR; PG8_SCHED;
            PG8_LDA(At, 0, 1); PG8_STAGE(PG8_SB(0, 0), b2, voffB); PG8_STAGE(PG8_SB(0, 1), b2 + hsB, voffB); PG8_STAGE(PG8_SA(0, 0), a2, voffA);
            PG8_WAIT_V(8); PG8_WAIT_L(0); PG8_BAR; PG8_MMA(1, 0, At, B0); PG8_MMA(1, 1, At, B1); PG8_BAR; PG8_SCHED;
            PG8_LDB(B0, 1, 0); PG8_LDB(B1, 1, 1); PG8_SCHED; PG8_LDA(At, 1, 0); PG8_STAGE(PG8_SA(0, 1), a2 + hsA, voffA);
            PG8_WAIT_V(8); PG8_WAIT_L(0); PG8_BAR; PG8_MMA(0, 0, At, B0); PG8_MMA(0, 1, At, B1); PG8_BAR; PG8_SCHED;
            PG8_LDA(At, 1, 1); PG8_STAGE(PG8_SB(1, 0), b3, voffB); PG8_STAGE(PG8_SB(1, 1), b3 + hsB, voffB); PG8_STAGE(PG8_SA(1, 0), a3, voffA);
            PG8_WAIT_V(8); PG8_WAIT_L(0); PG8_BAR; PG8_MMA(1, 0, At, B0); PG8_MMA(1, 1, At, B1); PG8_BAR; PG8_SCHED;
            } else {
            PG8_LDB(B0, 0, 0); PG8_SCHED; PG8_LDA(At, 0, 0); PG8_STAGE(PG8_SA(1, 1), a1 + hsA, voffA);
            PG8_WAIT_L(8); PG8_BAR; PG8_WAIT_L(0); PG8_MMA(0, 0, At, B0); PG8_BAR; PG8_SCHED;
            PG8_LDB(B1, 0, 1); PG8_STAGE(PG8_SB(0, 0), b2, voffB);
            PG8_BAR; PG8_WAIT_L(0); PG8_MMA(0, 1, At, B1); PG8_BAR;
            PG8_LDA(At, 0, 1); PG8_STAGE(PG8_SA(0, 0), a2, voffA);
            PG8_BAR; PG8_WAIT_L(0); PG8_MMA(1, 0, At, B0); PG8_BAR; PG8_SCHED;
            PG8_STAGE(PG8_SB(0, 1), b2 + hsB, voffB);
            PG8_WAIT_V(6); PG8_BAR; PG8_MMA(1, 1, At, B1); PG8_BAR;
            PG8_LDB(B0, 1, 0); PG8_SCHED; PG8_LDA(At, 1, 0); PG8_STAGE(PG8_SA(0, 1), a2 + hsA, voffA);
            PG8_WAIT_L(8); PG8_BAR; PG8_WAIT_L(0); PG8_MMA(0, 0, At, B0); PG8_BAR; PG8_SCHED;
            PG8_LDB(B1, 1, 1); PG8_STAGE(PG8_SB(1, 0), b3, voffB);
            PG8_BAR; PG8_WAIT_L(0); PG8_MMA(0, 1, At, B1); PG8_BAR;
            PG8_LDA(At, 1, 1); PG8_STAGE(PG8_SA(1, 0), a3, voffA);
            PG8_BAR; PG8_WAIT_L(0); PG8_MMA(1, 0, At, B0); PG8_BAR; PG8_SCHED;
            PG8_STAGE(PG8_SB(1, 1), b3 + hsB, voffB);
            PG8_WAIT_V(6); PG8_BAR; PG8_MMA(1, 1, At, B1); PG8_BAR;
            }
        }
        if constexpr (ALIGN_EPI) { if (wr == 0) PG8_BAR; }
        if constexpr (!Epi::AFTER_DRAIN) { E(acc, cur, wr, wc, fr, fq); S.done(cur); }
        if (!has_next) break;
#pragma unroll
        for (int a = 0; a < 2; ++a)
#pragma unroll
            for (int b = 0; b < 2; ++b)
#pragma unroll
                for (int m = 0; m < 4; ++m)
#pragma unroll
                    for (int n = 0; n < 2; ++n) acc[a][b][m][n] = (f32x4){0.f, 0.f, 0.f, 0.f};
        cur = nxt; cA = nA; cB = nB; ++ui;
        if constexpr (ALIGN_EPI) { if (wr == 1) PG8_BAR; }
    }
    PG8_WAIT_V(0);
    if constexpr (!ALIGN_EPI) { if (wr == 0) PG8_BAR; }
    PG8_BAR;
    if constexpr (Epi::AFTER_DRAIN) { E.fused(acc, cur, wr, wc, fr, fq, lds, wid, lane); S.done(cur); }
#undef PG8_SA
#undef PG8_SB
#undef PG8_STAGE
#undef PG8_LDA
#undef PG8_LDB
#undef PG8_MMA
#undef PG8_WAIT_V
#undef PG8_WAIT_L
#undef PG8_BAR
#undef PG8_SCHED
}
}
#define PG8_SP2 true
#define PG8_ALIGN true
namespace attn_body {
typedef unsigned short bf16;
__device__ __forceinline__ unsigned f2bf_(float f){unsigned u=__builtin_bit_cast(unsigned,f);return (u+0x7fffu+((u>>16)&1u))>>16;}
using bf16x8=__attribute__((ext_vector_type(8)))short;
using s16x4=__attribute__((ext_vector_type(4)))short;
using f32x16=__attribute__((ext_vector_type(16)))float;
using u32x4=__attribute__((ext_vector_type(4)))unsigned;
constexpr int D=64,QP=768,KP=128;
constexpr int NW=8,QBLK=32,QB=QBLK*NW,KVBLK=64;
__device__ __forceinline__ int crow(int r,int hi){return (r&3)+8*(r>>2)+4*hi;}
#define SBAR() __builtin_amdgcn_sched_barrier(0)
constexpr int NSLOT=3, SLOTB=8192;
constexpr int LDS_K=0, LDS_V=NSLOT*SLOTB, LDS_WS=2*NSLOT*SLOTB, LDS_OST=LDS_WS+NW*64*4, LDS_BYTES=LDS_OST+NW*4096;
constexpr float C2=0.125f*1.4426950408889634f;
__device__ __forceinline__ void glds16(const void*gsrc,unsigned lds_dst){unsigned keep;
  asm volatile("s_mov_b32 %0, m0\n\ts_mov_b32 m0, %2\n\ts_nop 0\n\tglobal_load_lds_dwordx4 %1, off\n\ts_mov_b32 m0, %0":"=&s"(keep):"v"(gsrc),"s"(lds_dst):"memory");}
__device__ __forceinline__ float max3f(float a,float b,float c){float r;asm("v_max3_f32 %0, %1, %2, %3":"=v"(r):"v"(a),"v"(b),"v"(c));return r;}
__device__ __forceinline__ float max2f(float a,float b){float r;asm("v_max_f32_e32 %0, %1, %2":"=v"(r):"v"(a),"v"(b));return r;}
__device__ __forceinline__ float fadd_s(float a,float b){float r;asm("v_add_f32_e32 %0, %1, %2":"=v"(r):"v"(a),"v"(b));return r;}
__device__ __forceinline__ float fsub_s(float a,float b){float r;asm("v_sub_f32_e32 %0, %1, %2":"=v"(r):"v"(a),"v"(b));return r;}
typedef float f32x2_t __attribute__((ext_vector_type(2))); typedef __bf16 bf16x2_t __attribute__((ext_vector_type(2)));
__device__ __forceinline__ unsigned cvtpk_s(float lo,float hi){f32x2_t v={lo,hi};bf16x2_t b=__builtin_convertvector(v,bf16x2_t);return __builtin_bit_cast(unsigned,b);}
#define WAIT_BAR(N) asm volatile("s_waitcnt vmcnt(" #N ") lgkmcnt(0)\n\ts_barrier":::"memory")

__device__ __forceinline__ void qkt(f32x16&p0,f32x16&p1,const char*Kslot,const bf16x8*qr,const f32x16&negm,int r32,int hi){
  const char*kb=Kslot+hi*1024+r32*16;
  #pragma unroll
  for(int d0=0;d0<4;++d0){
    const bf16x8 b0=*reinterpret_cast<const bf16x8*>(kb+d0*2048);
    const bf16x8 b1=*reinterpret_cast<const bf16x8*>(kb+d0*2048+512);
    if(d0==0){p0=__builtin_amdgcn_mfma_f32_32x32x16_bf16(b0,qr[0],negm,0,0,0);p1=__builtin_amdgcn_mfma_f32_32x32x16_bf16(b1,qr[0],negm,0,0,0);}
    else{p0=__builtin_amdgcn_mfma_f32_32x32x16_bf16(b0,qr[d0],p0,0,0,0);p1=__builtin_amdgcn_mfma_f32_32x32x16_bf16(b1,qr[d0],p1,0,0,0);}}
}
typedef __attribute__((address_space(3))) const char* lds_cptr;
typedef short v4i16_t __attribute__((ext_vector_type(4)));
__device__ __forceinline__ void kload8(bf16x8*kf,lds_cptr kp){
  kf[0]=*(const __attribute__((address_space(3))) bf16x8*)(kp);      kf[1]=*(const __attribute__((address_space(3))) bf16x8*)(kp+512);
  kf[2]=*(const __attribute__((address_space(3))) bf16x8*)(kp+2048); kf[3]=*(const __attribute__((address_space(3))) bf16x8*)(kp+2560);
  kf[4]=*(const __attribute__((address_space(3))) bf16x8*)(kp+4096); kf[5]=*(const __attribute__((address_space(3))) bf16x8*)(kp+4608);
  kf[6]=*(const __attribute__((address_space(3))) bf16x8*)(kp+6144); kf[7]=*(const __attribute__((address_space(3))) bf16x8*)(kp+6656);
}
__device__ __forceinline__ void kload2(bf16x8*kf,lds_cptr kp,int j){ kf[2*j]=*(const __attribute__((address_space(3))) bf16x8*)(kp+j*2048); kf[2*j+1]=*(const __attribute__((address_space(3))) bf16x8*)(kp+j*2048+512); }
__device__ __forceinline__ s16x4 vtr(lds_cptr p){ return __builtin_bit_cast(s16x4,__builtin_amdgcn_ds_read_tr16_b64_v4i16((__attribute__((address_space(3))) v4i16_t*)p)); }
__device__ __forceinline__ float rowmax(const f32x16&p0,const f32x16&p1){
  float a=max3f(p0[0],p0[1],p1[0]),b=max3f(p0[2],p0[3],p1[1]);a=max3f(a,p1[2],p1[3]);
  #pragma unroll
  for(int r=4;r<16;r+=4){a=max3f(a,p0[r],p0[r+1]);b=max3f(b,p0[r+2],p0[r+3]);a=max3f(a,p1[r],p1[r+1]);b=max3f(b,p1[r+2],p1[r+3]);}
  const float m=max2f(a,b);
  auto rr=__builtin_amdgcn_permlane32_swap(__float_as_uint(m),__float_as_uint(m),false,false);
  return max2f(__uint_as_float(rr[0]),__uint_as_float(rr[1]));
}
__device__ __forceinline__ void pv(f32x16*o,int vb,bf16x8 pa0,bf16x8 pa1,bf16x8 pa2,bf16x8 pa3){
  #pragma unroll
  for(int d0=0;d0<2;++d0){s16x4 lo[4],hi[4];
    #pragma unroll
    for(int ks=0;ks<4;++ks){
      asm volatile("ds_read_b64_tr_b16 %0,%1 offset:%c2":"=&v"(lo[ks]):"v"(vb),"i"(d0*4096+ks*1024):"memory");
      asm volatile("ds_read_b64_tr_b16 %0,%1 offset:%c2":"=&v"(hi[ks]):"v"(vb),"i"(d0*4096+ks*1024+512):"memory");}
    asm volatile("s_waitcnt lgkmcnt(0)":::"memory");SBAR();
    #define PK(k) (bf16x8){lo[k][0],lo[k][1],lo[k][2],lo[k][3],hi[k][0],hi[k][1],hi[k][2],hi[k][3]}
    o[d0]=__builtin_amdgcn_mfma_f32_32x32x16_bf16(pa0,PK(0),o[d0],0,0,0);
    o[d0]=__builtin_amdgcn_mfma_f32_32x32x16_bf16(pa1,PK(1),o[d0],0,0,0);
    o[d0]=__builtin_amdgcn_mfma_f32_32x32x16_bf16(pa2,PK(2),o[d0],0,0,0);
    o[d0]=__builtin_amdgcn_mfma_f32_32x32x16_bf16(pa3,PK(3),o[d0],0,0,0);
    #undef PK
  }
}

#ifndef ATTN_STORE16
#define ATTN_STORE16(p,v) (*(u32x4*)(p)=(v))
#endif
template<int THRL,int NT> __device__ __forceinline__ void attn_unit(const bf16*Qu,const bf16*__restrict__ Kh,const bf16*__restrict__ Vh,bf16*Ou,char*shm){
  const int tid=threadIdx.x,lane=tid&63,r32=lane&31,hi=lane>>5; const int wid=__builtin_amdgcn_readfirstlane(tid>>6);
  const bf16*Qw=Qu+(long)(wid*QBLK)*QP;
  const unsigned lds0=(unsigned)(uintptr_t)shm;
  float*wsf=(float*)(shm+LDS_WS)+wid*64;
  const bf16*ksrc=Kh+(long)lane*KP+wid*8;
  const bf16*vsrc=Vh+(long)(16*(wid&3)+(lane>>2))*KP+(wid>>2)*32+(lane&3)*8;
  const unsigned kdst=lds0+LDS_K+wid*1024, vdst=lds0+LDS_V+wid*1024;
  #define DMA_K(t,slot) glds16(ksrc+(long)(t)*KVBLK*KP,(unsigned)__builtin_amdgcn_readfirstlane(kdst+(slot)))
  #define DMA_V(t,slot) glds16(vsrc+(long)(t)*KVBLK*KP,(unsigned)__builtin_amdgcn_readfirstlane(vdst+(slot)))
  const int vb0=(int)(lds0+LDS_V)+((lane>>4)&1)*32+(lane&3)*8+(4*hi+((lane&15)>>2))*64;
  const char*Kbase=shm+LDS_K; bf16x8 kf[8];
  const lds_cptr shm3=(lds_cptr)shm; const lds_cptr kp0=shm3+LDS_K+hi*1024+r32*16; const lds_cptr vp0=shm3+LDS_V+((lane>>4)&1)*32+(lane&3)*8+(4*hi+((lane&15)>>2))*64;
  static_assert(NT>=4&&(NT&1)==0,"NT even, >= 4");
  DMA_K(0,0);DMA_V(0,0);DMA_K(1,SLOTB);
  bf16x8 qr[4];
  #pragma unroll
  for(int d0=0;d0<4;++d0)qr[d0]=*reinterpret_cast<const bf16x8*>(&Qw[(long)r32*QP+d0*16+hi*8]);
  float mhat=0.f,l_reg=0.f;f32x16 o[2];o[0]=f32x16{};o[1]=f32x16{};f32x16 negm=f32x16{};asm volatile("":"+v"(negm));
  bool resc=false;
  #define START(P0,P1) do{ const float rm=rowmax(P0,P1); resc=false; \
    { const float dl=rm; mhat=fadd_s(mhat,dl); \
      _Pragma("unroll") for(int r=0;r<16;++r){P0[r]=fsub_s(P0[r],dl);P1[r]=fsub_s(P1[r],dl);} \
      _Pragma("unroll") for(int r=0;r<16;++r)negm[r]=-mhat; asm volatile("":"+v"(negm)); } \
    _Pragma("unroll") for(int r=0;r<16;++r)P0[r]=__builtin_amdgcn_exp2f(P0[r]); }while(0)
  #define RESC() do{ if(resc){ asm volatile("s_waitcnt lgkmcnt(0)":::"memory"); \
      _Pragma("unroll") for(int d_=0;d_<2;++d_) _Pragma("unroll") for(int r=0;r<16;++r)o[d_][r]*=wsf[crow(r,hi)]; } }while(0)
  f32x16 pA0,pA1,pB0,pB1;
  int sl_prev=0,sl_cur=0,sl_next=SLOTB;
  #define ROT() do{sl_prev=sl_cur;sl_cur=sl_next;sl_next=(sl_next==(NSLOT-1)*SLOTB)?0:sl_next+SLOTB;}while(0)
  DMA_K(2,2*SLOTB);
  WAIT_BAR(3);
  qkt(pA0,pA1,Kbase,qr,negm,r32,hi);asm volatile("s_nop 15\n\ts_nop 7":"+v"(pA0),"+v"(pA1));
  START(pA0,pA1);
  _Pragma("unroll") for(int r=0;r<16;++r)pA1[r]=__builtin_amdgcn_exp2f(pA1[r]);
  WAIT_BAR(0);
  DMA_K(3,0);DMA_V(1,SLOTB);
  ROT();
  kload8(kf,kp0+sl_cur);
  WAIT_BAR(2);
  s16x4 vlo[8],vhi[8]; u32x4 pw0,pw1,pw2,pw3;
  #define PKW(P,B) cvtpk_s(P[B],P[B+1])
  #define PAF(k) __builtin_bit_cast(bf16x8,pw##k)
  #define VFR(i) (bf16x8){vlo[i][0],vlo[i][1],vlo[i][2],vlo[i][3],vhi[i][0],vhi[i][1],vhi[i][2],vhi[i][3]}
  #define PIN(x) asm volatile("":"+v"(x))
  #define MX3(a,b,c) __builtin_fmaxf(__builtin_fmaxf((a),(b)),(c))
  #define GAPA(MF,A0,A1,A2,A3,W0,W1,PW) do{ MF; sacc+=A0; sacc+=A1; sacc+=A2; sacc+=A3; PIN(sacc); W0; W1; PIN(PW); SBAR(); }while(0)
  #define EX(v) __builtin_amdgcn_exp2f(v)
  #define GAPB(MF,X,B) do{ MF; X[B]=EX(X[B]); X[B+1]=EX(X[B+1]); X[B+2]=EX(X[B+2]); X[B+3]=EX(X[B+3]); PIN(X); SBAR(); }while(0)
  #define VRD(i) do{ vlo[i]=vtr(vp_+(((i)>>2)*4096+((i)&3)*1024)); vhi[i]=vtr(vp_+(((i)>>2)*4096+((i)&3)*1024+512)); }while(0)
  #define KRD(G,j) do{ if(G){ kload2(kf,kp0+sl_next,j); SBAR(); } }while(0)
  #define STEP(C0,C1,P0,P1,t,GK,GV,GL) do{ SBAR(); \
    const lds_cptr vp_=vp0+sl_prev; \
    VRD(0); SBAR(); float sacc=(P0[0]+P0[1]); \
    GAPA(C0=__builtin_amdgcn_mfma_f32_32x32x16_bf16(kf[0],qr[0],negm,0,0,0), P0[2],P0[3],P0[4],P0[5],     pw0[0]=PKW(P0,0), pw0[1]=PKW(P0,2), pw0); \
    VRD(4); SBAR(); GAPA(C1=__builtin_amdgcn_mfma_f32_32x32x16_bf16(kf[1],qr[0],negm,0,0,0), P0[6],P0[7],P0[8],P0[9],     pw0[2]=PKW(P0,4), pw0[3]=PKW(P0,6), pw0); \
    VRD(1); SBAR(); GAPA(C0=__builtin_amdgcn_mfma_f32_32x32x16_bf16(kf[2],qr[1],C0,0,0,0),   P0[10],P0[11],P0[12],P0[13], pw1[0]=PKW(P0,8), pw1[1]=PKW(P0,10), pw1); \
    VRD(5); SBAR(); GAPA(C1=__builtin_amdgcn_mfma_f32_32x32x16_bf16(kf[3],qr[1],C1,0,0,0),   P0[14],P0[15],P1[0],P1[1],   pw1[2]=PKW(P0,12),pw1[3]=PKW(P0,14), pw1); \
    VRD(2); SBAR(); GAPA(C0=__builtin_amdgcn_mfma_f32_32x32x16_bf16(kf[4],qr[2],C0,0,0,0),   P1[2],P1[3],P1[4],P1[5],     pw2[0]=PKW(P1,0), pw2[1]=PKW(P1,2), pw2); \
    VRD(6); SBAR(); GAPA(C1=__builtin_amdgcn_mfma_f32_32x32x16_bf16(kf[5],qr[2],C1,0,0,0),   P1[6],P1[7],P1[8],P1[9],     pw2[2]=PKW(P1,4), pw2[3]=PKW(P1,6), pw2); \
    VRD(3); SBAR(); GAPA(C0=__builtin_amdgcn_mfma_f32_32x32x16_bf16(kf[6],qr[3],C0,0,0,0),   P1[10],P1[11],P1[12],P1[13], pw3[0]=PKW(P1,8), pw3[1]=PKW(P1,10), pw3); \
    VRD(7); SBAR(); GAPA(C1=__builtin_amdgcn_mfma_f32_32x32x16_bf16(kf[7],qr[3],C1,0,0,0),   P1[14],P1[15],0.f,0.f,       pw3[2]=PKW(P1,12),pw3[3]=PKW(P1,14), pw3); \
    l_reg+=sacc; \
    if(GK){DMA_K((t)+3,sl_cur);} if(GV){DMA_V((t)+1,sl_next);} \
    { float a=MX3(C0[0],C0[1],C1[0]),b=MX3(C0[2],C0[3],C1[1]); a=MX3(a,C1[2],C1[3]); \
      _Pragma("unroll") for(int r=4;r<16;r+=4){a=MX3(a,C0[r],C0[r+1]);b=MX3(b,C0[r+2],C0[r+3]);a=MX3(a,C1[r],C1[r+1]);b=MX3(b,C1[r+2],C1[r+3]);} \
      float rm=__builtin_fmaxf(a,b); { auto rr=__builtin_amdgcn_permlane32_swap(__float_as_uint(rm),__float_as_uint(rm),false,false); rm=__builtin_fmaxf(__uint_as_float(rr[0]),__uint_as_float(rr[1])); } \
      resc=false; \
      if(__builtin_expect(__any(rm>(float)THRL),0)){ const float dl=__builtin_fmaxf(rm,0.f); mhat+=dl; \
        _Pragma("unroll") for(int r=0;r<16;++r){C0[r]-=dl;C1[r]-=dl;} \
        _Pragma("unroll") for(int r=0;r<16;++r)negm[r]=-mhat; asm volatile("":"+v"(negm)); \
        const float f=__builtin_amdgcn_exp2f(-dl); l_reg*=f; if(hi==0)wsf[r32]=f; resc=true; } } \
    SBAR(); \
    GAPB(o[0]=__builtin_amdgcn_mfma_f32_32x32x16_bf16(PAF(0),VFR(0),o[0],0,0,0), C0,0); \
    GAPB(o[1]=__builtin_amdgcn_mfma_f32_32x32x16_bf16(PAF(0),VFR(4),o[1],0,0,0), C0,4); \
    KRD(GL,0); GAPB(o[0]=__builtin_amdgcn_mfma_f32_32x32x16_bf16(PAF(1),VFR(1),o[0],0,0,0), C0,8); \
    KRD(GL,1); GAPB(o[1]=__builtin_amdgcn_mfma_f32_32x32x16_bf16(PAF(1),VFR(5),o[1],0,0,0), C0,12); \
    KRD(GL,2); GAPB(o[0]=__builtin_amdgcn_mfma_f32_32x32x16_bf16(PAF(2),VFR(2),o[0],0,0,0), C1,0); \
    KRD(GL,3); GAPB(o[1]=__builtin_amdgcn_mfma_f32_32x32x16_bf16(PAF(2),VFR(6),o[1],0,0,0), C1,4); \
    GAPB(o[0]=__builtin_amdgcn_mfma_f32_32x32x16_bf16(PAF(3),VFR(3),o[0],0,0,0), C1,8); \
    GAPB(o[1]=__builtin_amdgcn_mfma_f32_32x32x16_bf16(PAF(3),VFR(7),o[1],0,0,0), C1,12); \
    }while(0)
  int t=1;
  for(;t+5<NT;t+=2){
    STEP(pB0,pB1,pA0,pA1,t,true,true,true);     WAIT_BAR(2); RESC(); ROT();
    STEP(pA0,pA1,pB0,pB1,t+1,true,true,true);   WAIT_BAR(2); RESC(); ROT();
  }
  #define ENDW(tt) do{ if((tt)+3<NT){WAIT_BAR(2);} else if((tt)+2<NT){WAIT_BAR(1);} else {WAIT_BAR(0);} }while(0)
  for(;t+1<NT;t+=2){
    STEP(pB0,pB1,pA0,pA1,t,(t+3<NT),(t+1<NT),(t+1<NT));       ENDW(t);   RESC(); ROT();
    STEP(pA0,pA1,pB0,pB1,t+1,(t+4<NT),(t+2<NT),(t+2<NT));     ENDW(t+1); RESC(); ROT();
  }
  STEP(pB0,pB1,pA0,pA1,NT-1,false,false,false); RESC();
  { float sacc=pB0[0]+pB0[1]; _Pragma("unroll") for(int r=2;r<16;++r)sacc+=pB0[r]; _Pragma("unroll") for(int r=0;r<16;++r)sacc+=pB1[r]; l_reg+=sacc;
    pw0=(u32x4){PKW(pB0,0),PKW(pB0,2),PKW(pB0,4),PKW(pB0,6)};pw1=(u32x4){PKW(pB0,8),PKW(pB0,10),PKW(pB0,12),PKW(pB0,14)};pw2=(u32x4){PKW(pB1,0),PKW(pB1,2),PKW(pB1,4),PKW(pB1,6)};pw3=(u32x4){PKW(pB1,8),PKW(pB1,10),PKW(pB1,12),PKW(pB1,14)};
    SBAR(); pv(o,vb0+sl_cur,PAF(0),PAF(1),PAF(2),PAF(3)); }
  #undef PKW
  #undef PAF
  #undef VFR
  #undef PIN
  #undef MX3
  #undef GAPA
  #undef GAPB
  #undef EX
  #undef VRD
  #undef KRD
  #undef STEP
  #undef ENDW
  {auto rr=__builtin_amdgcn_permlane32_swap(__float_as_uint(l_reg),__float_as_uint(l_reg),false,false);l_reg=__uint_as_float(rr[0])+__uint_as_float(rr[1]);}
  if(hi==0)wsf[32+r32]=l_reg;asm volatile("s_waitcnt lgkmcnt(0)":::"memory");
  float rli[16];
  #pragma unroll
  for(int r=0;r<16;++r)rli[r]=__builtin_amdgcn_rcpf(wsf[32+crow(r,hi)]);
  bf16*Ow=Ou+(long)(wid*QBLK)*QP;
  { bf16*stg=(bf16*)(shm+LDS_OST)+wid*2048;
    #pragma unroll
    for(int r=0;r<16;++r){const int orow=crow(r,hi);
      #pragma unroll
      for(int d0=0;d0<2;++d0)stg[orow*64+d0*32+r32]=(bf16)f2bf_(o[d0][r]*rli[r]);}
    asm volatile("s_waitcnt lgkmcnt(0)":::"memory");
    #pragma unroll
    for(int i=0;i<4;++i){const int row=i*8+(lane>>3),ch=lane&7; const u32x4 v=*(const u32x4*)(stg+row*64+ch*8); ATTN_STORE16(Ow+(long)row*QP+ch*8,v);} }
  asm volatile("s_waitcnt lgkmcnt(0)\n\ts_barrier":::"memory");
  #undef DMA_K
  #undef DMA_V
  #undef START
  #undef RESC
  #undef ROT
}
constexpr int ATTN_LDS_BYTES=LDS_BYTES;
#undef SBAR
#undef WAIT_BAR
}
#define GAS __attribute__((address_space(1)))
#define LAS __attribute__((address_space(3)))
typedef unsigned short bf16;
typedef unsigned v4u __attribute__((ext_vector_type(4)));
typedef float f32x4 __attribute__((ext_vector_type(4)));
typedef short bf16x8 __attribute__((ext_vector_type(8)));
typedef GAS unsigned gu32;
typedef GAS unsigned long long gu64;
#define RLX_AGENT __ATOMIC_RELAXED, __HIP_MEMORY_SCOPE_AGENT
#define LDS_WAIT() asm volatile("s_waitcnt lgkmcnt(0)" ::: "memory")
#define VM_WAIT() asm volatile("s_waitcnt vmcnt(0)" ::: "memory")
__device__ __forceinline__ unsigned long long rt() { return __builtin_amdgcn_s_memrealtime(); }
__device__ __forceinline__ unsigned f2bf(float f) { unsigned u = __builtin_bit_cast(unsigned, f); return (u + 0x7fffu + ((u >> 16) & 1u)) >> 16; }
__device__ __forceinline__ unsigned pk2(float lo, float hi) { return f2bf(lo) | (f2bf(hi) << 16); }

#define XB_TMO      128
#define XB_XCNT(j)  (256  + 64 * (j))
#define XB_XSUB(j)  (1280 + 64 * (j))
#define XB_XGEN(j)  (2304 + 64 * (j))
#define XB_TOP      3328
#define XB_TOPGEN   3392
#define XCD_BAR_WORDS 3456
#define XB_SPIN_CAP (1u << 18)

__device__ __forceinline__ unsigned xb_ld(unsigned* p)              { return __hip_atomic_load(p, __ATOMIC_RELAXED, __HIP_MEMORY_SCOPE_AGENT); }
__device__ __forceinline__ unsigned xb_add(unsigned* p, unsigned v) { return __hip_atomic_fetch_add(p, v, __ATOMIC_RELAXED, __HIP_MEMORY_SCOPE_AGENT); }
__device__ __forceinline__ unsigned xb_xcc_id() { return (unsigned)__builtin_amdgcn_s_getreg((3 << 11) | 20) & 0xFu; }
#define XB_SPIN(cond, bar) do { unsigned _sp = 0; while (cond) { __builtin_amdgcn_s_sleep(1); \
    if ((++_sp & 255u) == 0u) { if (xb_ld(&(bar)[XB_TMO])) break; if (_sp > XB_SPIN_CAP) { atomicAdd(&(bar)[XB_TMO], 1u); break; } } } } while (0)

struct XcdBarrier {
    unsigned* bar; unsigned x;
    volatile LAS unsigned* st;
};

__device__ __forceinline__ XcdBarrier xcd_barrier_post(unsigned* bar, volatile LAS unsigned* st) {
    XcdBarrier b; b.bar = bar; b.x = xb_xcc_id(); b.st = st;
    if (threadIdx.x == 0) (void)xb_add(&bar[XB_XCNT(b.x)], 1u);
    return b;
}
__device__ __forceinline__ void xcd_barrier_complete(unsigned* bar, unsigned x, unsigned& nloc, unsigned& nx) {
    const unsigned G = gridDim.x * gridDim.y * gridDim.z;
    unsigned sum, cnt, mine, sp = 0u;
    for (;;) {
        sum = 0u; cnt = 0u; mine = 0u;
#pragma unroll
        for (unsigned j = 0; j < 16; ++j) { const unsigned c = xb_ld(&bar[XB_XCNT(j)]); sum += c; cnt += (c > 0u) ? 1u : 0u; mine = (j == x) ? c : mine; }
        if (sum == G) break;
        __builtin_amdgcn_s_sleep(1);
        if ((++sp & 255u) == 0u) { if (xb_ld(&bar[XB_TMO])) break; if (sp > XB_SPIN_CAP) { atomicAdd(&bar[XB_TMO], 1u); break; } }
    }
    nloc = mine > 0u ? mine : 1u; nx = cnt > 0u ? cnt : 1u;
}

__device__ __forceinline__ void xcd_barrier(const XcdBarrier& b) {
    asm volatile("s_waitcnt vmcnt(0)" ::: "memory");
    __syncthreads();
    if (threadIdx.x == 0) {
        unsigned* bar = b.bar;
        __builtin_amdgcn_s_waitcnt(0);
        unsigned nloc = b.st[0], nx = b.st[1];
        if (nloc == 0u) { xcd_barrier_complete(bar, b.x, nloc, nx); b.st[0] = nloc; b.st[1] = nx; }
        const unsigned old = xb_add(&bar[XB_XSUB(b.x)], 1u);
        const unsigned gen = old / nloc;
        if (old + 1u == (gen + 1u) * nloc) {
            __builtin_amdgcn_fence(__ATOMIC_RELEASE, "agent");
            asm volatile("s_waitcnt vmcnt(0)" ::: "memory");
            const unsigned og = xb_add(&bar[XB_TOP], 1u);
            const unsigned tg = og / nx;
            if (og + 1u == (tg + 1u) * nx) xb_add(&bar[XB_TOPGEN], 1u);
            else XB_SPIN(xb_ld(&bar[XB_TOPGEN]) == tg, bar);
            __builtin_amdgcn_fence(__ATOMIC_ACQUIRE, "agent");
            xb_add(&bar[XB_XGEN(b.x)], 1u);
            asm volatile("s_waitcnt vmcnt(0)" ::: "memory");
        } else {
            XB_SPIN(xb_ld(&bar[XB_XGEN(b.x)]) == gen, bar);
            __builtin_amdgcn_fence(__ATOMIC_ACQUIRE, "agent");
            asm volatile("s_waitcnt vmcnt(0)" ::: "memory");
        }
    }
    __syncthreads();
}
__device__ __forceinline__ float wave_sum(float v) {
#pragma unroll
    for (int o = 1; o < 64; o <<= 1) v += __shfl_xor(v, o);
    return v;
}
__device__ __forceinline__ void p0_transpose_item(const float* W, int K, int N, bf16* WT, int row_off, LAS float* scr, int item, int lane) {
    const int nblk = N / 32, kb = item / nblk, nb = item % nblk, k0 = 64 * kb, n0 = 32 * nb;
#pragma unroll 8
    for (int i = 0; i < 32; ++i) { const int kk = 2 * i + (lane >> 5); scr[kk * 33 + (lane & 31)] = W[(size_t)(k0 + kk) * N + n0 + (lane & 31)]; }
    LDS_WAIT(); asm volatile("" ::: "memory");
    const int c = lane & 7;
#pragma unroll
    for (int j = 0; j < 4; ++j) { const int n = (lane >> 3) + 8 * j; const LAS float* s = scr + (8 * c) * 33 + n;
        v4u o; o.x = pk2(s[0 * 33], s[1 * 33]); o.y = pk2(s[2 * 33], s[3 * 33]); o.z = pk2(s[4 * 33], s[5 * 33]); o.w = pk2(s[6 * 33], s[7 * 33]);
        *(GAS v4u*)(WT + (size_t)(row_off + n0 + n) * K + k0 + 8 * c) = o; }
    LDS_WAIT(); asm volatile("" ::: "memory");
}
namespace hg {
typedef short bf16x8 __attribute__((ext_vector_type(8)));
typedef short v4i16 __attribute__((ext_vector_type(4)));
typedef float f32x16 __attribute__((ext_vector_type(16)));
typedef float f32x4 __attribute__((ext_vector_type(4)));
typedef unsigned u32x2 __attribute__((ext_vector_type(2)));
typedef unsigned u32x4 __attribute__((ext_vector_type(4)));
constexpr int ROWB = 272, TROWB = 80, VROWB = 320, FROWB = 512, QROWB = 256;
constexpr int OFF_F = 0, OFF_RQ = 16384, OFF_V = 24576, OFF_QDT = 34816, OFF_KDT = 45056, OFF_ST = 55296, OFF_SC = 90112, OFF_PL = 100352, OFF_GP = 100864, LDS_END = 102912;
__device__ __forceinline__ int crow(int r, int hi) { return (r & 3) + 8 * (r >> 2) + 4 * hi; }
__device__ __forceinline__ unsigned f2bf(float f) { unsigned u = __builtin_bit_cast(unsigned, f); return (u + 0x7fffu + ((u >> 16) & 1u)) >> 16; }
__device__ __forceinline__ float bflo(unsigned w) { return __uint_as_float(w << 16); }
__device__ __forceinline__ float bfhi(unsigned w) { return __uint_as_float(w & 0xffff0000u); }
__device__ __forceinline__ void lbar() { asm volatile("s_waitcnt lgkmcnt(0)" ::: "memory"); __builtin_amdgcn_s_barrier(); asm volatile("" ::: "memory"); }
__device__ __forceinline__ v4i16 trd(const LAS unsigned char* p) { return __builtin_amdgcn_ds_read_tr16_b64_v4i16((LAS v4i16*)p); }
__device__ __forceinline__ bf16x8 trfrag(const LAS unsigned char* p, int rs) { const v4i16 a = trd(p), b = trd(p + 4 * rs); return (bf16x8){a[0], a[1], a[2], a[3], b[0], b[1], b[2], b[3]}; }
__device__ __forceinline__ void st_image(LAS unsigned char* lds, const f32x16& S, int cb, int vb, int r, int hh) {
    LAS unsigned char* p = lds + OFF_ST + (32 * vb + r) * ROWB + (32 * cb + 4 * hh) * 2;
#pragma unroll
    for (int q4 = 0; q4 < 4; ++q4) { u32x2 w; w.x = f2bf(S[4 * q4]) | (f2bf(S[4 * q4 + 1]) << 16); w.y = f2bf(S[4 * q4 + 2]) | (f2bf(S[4 * q4 + 3]) << 16); *(LAS u32x2*)(p + 16 * q4) = w; }
}
__device__ __forceinline__ void hgrn_unit(LAS unsigned char* lds, const unsigned short* ZH, float* odir, int row0, int L, int h, int dir, const float* s0, float* sfin, const float* lbl) {
    const int tid = threadIdx.x, lane = tid & 63, wid = __builtin_amdgcn_readfirstlane(tid >> 6), r = lane & 31, hh = lane >> 5;
    const int c = (wid & 1) * 64 + lane, g = wid >> 1;
    const int li = tid >> 4, cg = tid & 15;
    const int vb = wid & 3; const bool swave = wid >= 4;
    const int nch = L >> 5;
    float oml[8];
#pragma unroll
    for (int e = 0; e < 8; ++e) { const float l0 = lbl[dir * 1024 + h * 128 + 8 * cg + e], l1 = lbl[dir * 1024 + 512 + h * 128 + 8 * cg + e]; oml[e] = 1.0f - 1.0f / (1.0f + __expf(l1 - l0)); }
    const unsigned short* zl = ZH + (size_t)row0 * 2560 + h * 128 + 8 * cg;
    const int foff = 512 + dir * 512;
    LAS float* PL = (LAS float*)(lds + OFF_PL); LAS float* GP = (LAS float*)(lds + OFF_GP);
    const int trq = (lane & 15) >> 2, trp = lane & 3, trg = (lane >> 4) & 1;
    const int tr80 = (8 * hh + trq) * TROWB + (16 * trg + 4 * trp) * 2;
    const int trv = (8 * hh + trq) * VROWB + (32 * vb + 16 * trg + 4 * trp) * 2;
    u32x4 aq, af, av, bq, bf, bv;
#define HG_ISSUE(m, Q_, F_, V_) do { int m_ = (m); m_ = m_ < nch ? m_ : nch - 1; const int p_ = 32 * m_ + li; const int t_ = dir ? (L - 1 - p_) : p_; const unsigned short* zp = zl + (size_t)t_ * 2560; \
        Q_ = *(const u32x4*)zp; F_ = *(const u32x4*)(zp + foff); V_ = *(const u32x4*)(zp + 1536); } while (0)
#define HG_WRITE_FQ(Q_, F_) do { float x_[8] = {bflo(F_.x), bfhi(F_.x), bflo(F_.y), bfhi(F_.y), bflo(F_.z), bfhi(F_.z), bflo(F_.w), bfhi(F_.w)}; float f_[8]; \
        _Pragma("unroll") for (int e = 0; e < 8; ++e) { const float sg = __builtin_amdgcn_rcpf(1.0f + __builtin_amdgcn_exp2f(-1.4426950408889634f * x_[e])); f_[e] = (1.0f - oml[e]) + oml[e] * sg; } \
        *(LAS f32x4*)(lds + OFF_F + li * FROWB + 32 * cg) = (f32x4){f_[0], f_[1], f_[2], f_[3]}; *(LAS f32x4*)(lds + OFF_F + li * FROWB + 32 * cg + 16) = (f32x4){f_[4], f_[5], f_[6], f_[7]}; \
        *(LAS u32x4*)(lds + OFF_RQ + li * QROWB + 16 * cg) = Q_; } while (0)
#define HG_WRITE_V(V_) do { *(LAS u32x4*)(lds + OFF_V + li * VROWB + 16 * cg) = V_; } while (0)
    f32x16 S0, S1, S2, S3;
    if (swave) {
#pragma unroll
        for (int q = 0; q < 16; ++q) {
            if (s0) { const float* sp = s0 + (size_t)crow(q, hh) * 128 + 32 * vb + r; S0[q] = sp[0]; S1[q] = sp[32 * 128]; S2[q] = sp[64 * 128]; S3[q] = sp[96 * 128]; }
            else { S0[q] = 0.f; S1[q] = 0.f; S2[q] = 0.f; S3[q] = 0.f; }
        }
        st_image(lds, S0, 0, vb, r, hh); st_image(lds, S1, 1, vb, r, hh); st_image(lds, S2, 2, vb, r, hh); st_image(lds, S3, 3, vb, r, hh);
    }
    HG_ISSUE(0, aq, af, av); HG_ISSUE(1, bq, bf, bv);
    HG_WRITE_FQ(aq, af); HG_WRITE_V(av);
    lbar();
#define HG_ITER(n, LQ, LF, LV, NQ, NF, NV, ROLE_S) do { \
        HG_ISSUE((n) + 2, LQ, LF, LV); \
          \
        float pp[8], qf[8], kk[8]; float p = 1.f; \
        _Pragma("unroll") for (int e = 0; e < 8; ++e) { const float f = *(const LAS float*)(lds + OFF_F + (8 * g + e) * FROWB + 4 * c); p *= f; pp[e] = p; kk[e] = 1.0f - f; \
            qf[e] = __uint_as_float((unsigned)*(const LAS unsigned short*)(lds + OFF_RQ + (8 * g + e) * QROWB + 2 * c) << 16) * 0.08838834764831845f; } \
        GP[g * 128 + c] = p; \
        lbar();                                                             \
        float pre = 1.f, pl = 1.f; \
        _Pragma("unroll") for (int g2 = 0; g2 < 4; ++g2) { const float gv = GP[g2 * 128 + c]; pl *= gv; if (g2 < g) pre *= gv; } \
        unsigned qb_[8], kb_[8]; \
        _Pragma("unroll") for (int e = 0; e < 8; ++e) { const float Pi = pre * pp[e]; qb_[e] = f2bf(qf[e] * Pi); kb_[e] = f2bf(kk[e] * __builtin_amdgcn_rcpf(Pi)); } \
        *(LAS u32x4*)(lds + OFF_QDT + c * TROWB + 16 * g) = (u32x4){qb_[0] | (qb_[1] << 16), qb_[2] | (qb_[3] << 16), qb_[4] | (qb_[5] << 16), qb_[6] | (qb_[7] << 16)}; \
        *(LAS u32x4*)(lds + OFF_KDT + c * TROWB + 16 * g) = (u32x4){kb_[0] | (kb_[1] << 16), kb_[2] | (kb_[3] << 16), kb_[4] | (kb_[5] << 16), kb_[6] | (kb_[7] << 16)}; \
        if (g == 0) PL[c] = pl; \
        lbar();                                                             \
        HG_WRITE_FQ(NQ, NF);                                                \
        if (!(ROLE_S)) { \
            f32x16 sc, o; \
            _Pragma("unroll") for (int q = 0; q < 16; ++q) { sc[q] = 0.f; o[q] = 0.f; } \
            bf16x8 qa[8]; \
            _Pragma("unroll") for (int s = 0; s < 8; ++s) { qa[s] = trfrag(lds + OFF_QDT + tr80 + 16 * s * TROWB, TROWB); const bf16x8 kb = trfrag(lds + OFF_KDT + tr80 + 16 * s * TROWB, TROWB); \
                sc = __builtin_amdgcn_mfma_f32_32x32x16_bf16(qa[s], kb, sc, 0, 0, 0); } \
            LAS unsigned short* SCw = (LAS unsigned short*)(lds + OFF_SC + vb * 2560); \
            _Pragma("unroll") for (int q = 0; q < 16; ++q) { const int i = crow(q, hh); SCw[i * (TROWB / 2) + r] = (unsigned short)f2bf(r <= i ? sc[q] : 0.f); } \
            asm volatile("s_waitcnt lgkmcnt(0)" ::: "memory");             \
            const LAS unsigned char* scp = (const LAS unsigned char*)SCw + r * TROWB + 16 * hh; \
            const LAS unsigned char* stp = lds + OFF_ST + (32 * vb + r) * ROWB + 16 * hh; \
            o = __builtin_amdgcn_mfma_f32_32x32x16_bf16(*(const LAS bf16x8*)(scp), trfrag(lds + OFF_V + trv, VROWB), o, 0, 0, 0); \
            o = __builtin_amdgcn_mfma_f32_32x32x16_bf16(*(const LAS bf16x8*)(scp + 32), trfrag(lds + OFF_V + trv + 16 * VROWB, VROWB), o, 0, 0, 0); \
            _Pragma("unroll") for (int s = 0; s < 8; ++s) o = __builtin_amdgcn_mfma_f32_32x32x16_bf16(qa[s], *(const LAS bf16x8*)(stp + 32 * s), o, 0, 0, 0); \
            _Pragma("unroll") for (int q = 0; q < 16; ++q) { const int p_ = 32 * (n) + crow(q, hh); const int t_ = dir ? (L - 1 - p_) : p_; \
                odir[(size_t)dir * 8388608 + (size_t)(row0 + t_) * 512 + h * 128 + 32 * vb + r] = o[q]; } \
        } else { \
            const bf16x8 vf0 = trfrag(lds + OFF_V + trv, VROWB), vf1 = trfrag(lds + OFF_V + trv + 16 * VROWB, VROWB); \
            const LAS unsigned char* kp = lds + OFF_KDT + r * TROWB + 16 * hh; \
            S0 = __builtin_amdgcn_mfma_f32_32x32x16_bf16(*(const LAS bf16x8*)(kp), vf0, S0, 0, 0, 0); S0 = __builtin_amdgcn_mfma_f32_32x32x16_bf16(*(const LAS bf16x8*)(kp + 32), vf1, S0, 0, 0, 0); \
            S1 = __builtin_amdgcn_mfma_f32_32x32x16_bf16(*(const LAS bf16x8*)(kp + 32 * TROWB), vf0, S1, 0, 0, 0); S1 = __builtin_amdgcn_mfma_f32_32x32x16_bf16(*(const LAS bf16x8*)(kp + 32 * TROWB + 32), vf1, S1, 0, 0, 0); \
            S2 = __builtin_amdgcn_mfma_f32_32x32x16_bf16(*(const LAS bf16x8*)(kp + 64 * TROWB), vf0, S2, 0, 0, 0); S2 = __builtin_amdgcn_mfma_f32_32x32x16_bf16(*(const LAS bf16x8*)(kp + 64 * TROWB + 32), vf1, S2, 0, 0, 0); \
            S3 = __builtin_amdgcn_mfma_f32_32x32x16_bf16(*(const LAS bf16x8*)(kp + 96 * TROWB), vf0, S3, 0, 0, 0); S3 = __builtin_amdgcn_mfma_f32_32x32x16_bf16(*(const LAS bf16x8*)(kp + 96 * TROWB + 32), vf1, S3, 0, 0, 0); \
            _Pragma("unroll") for (int q = 0; q < 16; ++q) { const int cc = crow(q, hh); S0[q] *= PL[cc]; S1[q] *= PL[32 + cc]; S2[q] *= PL[64 + cc]; S3[q] *= PL[96 + cc]; } \
        } \
        lbar();                                                             \
        HG_WRITE_V(NV); \
        if (ROLE_S) { st_image(lds, S0, 0, vb, r, hh); st_image(lds, S1, 1, vb, r, hh); st_image(lds, S2, 2, vb, r, hh); st_image(lds, S3, 3, vb, r, hh); } \
    } while (0)
    if (swave) { for (int n = 0; n < nch; n += 2) { HG_ITER(n, aq, af, av, bq, bf, bv, true); HG_ITER(n + 1, bq, bf, bv, aq, af, av, true); } }
    else { for (int n = 0; n < nch; n += 2) { HG_ITER(n, aq, af, av, bq, bf, bv, false); HG_ITER(n + 1, bq, bf, bv, aq, af, av, false); } }
    lbar();
    if (sfin && swave) {
#pragma unroll
        for (int q = 0; q < 16; ++q) { float* sp = sfin + (size_t)crow(q, hh) * 128 + 32 * vb + r; sp[0] = S0[q]; sp[32 * 128] = S1[q]; sp[64 * 128] = S2[q]; sp[96 * 128] = S3[q]; }
    }
#undef HG_ISSUE
#undef HG_WRITE_FQ
#undef HG_WRITE_V
#undef HG_ITER
}
}
constexpr int NWAVES = 8;
#ifndef MK_N_LAUNCHES
#define MK_N_LAUNCHES 1
#endif
constexpr int NPH = 12;
constexpr int N_LAUNCHES = MK_N_LAUNCHES;
constexpr int DMODEL = 1024, MROWS = 16384, MCTX = 8192, NZ = 5376, FFD = 4096;
constexpr int ZH_LD = 2560, ZA_LD = 768, ZG_LD = 2048;
constexpr float EPSN = 1e-6f;
constexpr float ATT_C2 = 0.125f * 1.4426950408889634f;
constexpr size_t OUT_Y = 0, OUT_CK = 16777216, OUT_CV = 17825792, OUT_ST = 18874368, OUT_TOTAL = 23068672;
constexpr size_t MiB = 1u << 20;
constexpr size_t WS_CTL = 0, CTL_ZERO_BYTES = 128 * 1024;
constexpr size_t WS_MOD = 1 * MiB, WS_ROPE = 1 * MiB + 512 * 1024;
constexpr size_t WS_WIN = 2 * MiB, WS_WHO = 13 * MiB, WS_WAO = 14 * MiB, WS_WOUT = 15 * MiB, WS_WF1 = 17 * MiB, WS_WF2 = 25 * MiB;
constexpr size_t WS_KC = 33 * MiB, WS_VC = 35 * MiB, WS_KL = 37 * MiB, WS_VL = 40 * MiB;
constexpr size_t WS_XN = 44 * MiB;
constexpr size_t WS_ZH = 76 * MiB, WS_ZA = 156 * MiB, WS_ZG = 180 * MiB, WS_END = 244 * MiB;
constexpr size_t WS_HB = 76 * MiB;
static_assert(WS_WIN + (size_t)NZ * DMODEL * 2 <= WS_WHO && WS_ZH + (size_t)MROWS * ZH_LD * 2 == WS_ZA && WS_ZA + (size_t)MROWS * ZA_LD * 2 == WS_ZG && WS_ZG + (size_t)MROWS * ZG_LD * 2 == WS_END, "d_ws map");
static_assert(WS_HB + (size_t)MROWS * FFD * 2 <= WS_END && WS_XN + (size_t)MROWS * DMODEL * 2 == WS_ZH && WS_VL + 3 * MiB <= WS_XN, "d_ws map 2");
constexpr int CW_QUEUE = 64;
constexpr int CW_BAR = 4096;
constexpr int RING_OFF = 0, RING_BYTES = 131072;
constexpr int LDSCTL_OFF = RING_BYTES, MISC_OFF = LDSCTL_OFF + 320;
constexpr int LDS_BYTES = 147456;
static_assert(MISC_OFF + 128 <= LDS_BYTES && hg::LDS_END <= RING_BYTES && attn_body::LDS_BYTES <= RING_BYTES, "LDS map");

struct Frame {
    LAS unsigned char* lds;
    volatile LAS unsigned* MISC;
    gu32* ctl;
    int tid, lane, wave;
    int vcu, G;
    const float *x_prompt, *x_sample, *cache_k, *cache_v, *state, *c, *c_ctx, *w_ada, *b_ada, *norm_mix_w, *w_in, *q_norm_w, *k_norm_w, *lb_logits, *hgrn_norm_w, *w_ho, *w_ao, *w_out, *norm_ffn_w, *w_ff1, *w_ff2, *final_w;
    float* out;
    float* MOD; float* ROPE;
    bf16 *WIN, *WHO, *WAO, *WOUT, *WF1, *WF2, *KC, *VC, *KL, *VL, *XN, *ZH, *ZA, *ZG, *HB;
};
__device__ __forceinline__ float bf2f(unsigned short h) { return __uint_as_float((unsigned)h << 16); }
__device__ __forceinline__ float bflo(unsigned w) { return __uint_as_float(w << 16); }
__device__ __forceinline__ float bfhi(unsigned w) { return __uint_as_float(w & 0xffff0000u); }
__device__ __forceinline__ float sigmf(float x) { return __builtin_amdgcn_rcpf(1.0f + __builtin_amdgcn_exp2f(-1.4426950408889634f * x)); }

__device__ __forceinline__ void p0_prologue(Frame& F) {
    {
        LAS float* sil = (LAS float*)(F.lds + RING_OFF);
        LAS float* red = sil + 9 * 1024;
        for (int i = F.tid; i < 9 * 1024; i += NWAVES * 64) { const int r = i >> 10, k = i & 1023; const float x = (r == 0) ? F.c_ctx[k] : F.c[(r - 1) * 1024 + k]; sil[i] = x * sigmf(x); }
        __syncthreads();
        for (int slab = blockIdx.x; slab < 256; slab += F.G) {
            const int n0 = 24 * slab, j = F.tid % 24, ks = F.tid / 24;
            float acc[9];
#pragma unroll
            for (int r = 0; r < 9; ++r) acc[r] = 0.f;
            if (F.tid < 504) {
                for (int k = ks; k < 1024; k += 21) { const float w = F.w_ada[(size_t)k * 6144 + n0 + j];
#pragma unroll
                    for (int r = 0; r < 9; ++r) acc[r] += sil[r * 1024 + k] * w; }
#pragma unroll
                for (int r = 0; r < 9; ++r) red[(ks * 9 + r) * 24 + j] = acc[r];
            }
            __syncthreads();
            if (F.tid < 216) { const int r = F.tid / 24, jj = F.tid % 24; float s = F.b_ada[n0 + jj];
                for (int k2 = 0; k2 < 21; ++k2) s += red[(k2 * 9 + r) * 24 + jj];
                F.MOD[(size_t)r * 6144 + n0 + jj] = s; }
            __syncthreads();
        }
    }
    if (blockIdx.x == 0) {
        for (int i = F.tid; i < 1024; i += NWAVES * 64) { const int pos = i >> 4, fi = i & 15;
            const float freq = __builtin_amdgcn_exp2f(-(float)fi * (13.287712379549449f / 16.0f));
            const float ang = (float)pos * freq; const float nrev = rintf(ang * 0.15915494309189535f);
            float rr = fmaf(-nrev, 6.28125f, ang); rr = fmaf(-nrev, 1.9353071795864769e-3f, rr);
            F.ROPE[2 * i] = __cosf(rr); F.ROPE[2 * i + 1] = __sinf(rr); }
    }
    LAS float* scr = (LAS float*)(F.lds + RING_OFF + F.wave * 16384);
    const int gw = F.vcu * NWAVES + F.wave, NGW = F.G * NWAVES;
    constexpr int I_IN = (1024 / 64) * (NZ / 32), I_HO = (512 / 64) * (1024 / 32), I_AO = I_HO, I_OUT = (1024 / 64) * (1024 / 32), I_F1 = (1024 / 64) * (FFD / 32), I_F2 = (FFD / 64) * (1024 / 32);
    constexpr int NITEMS = I_IN + I_HO + I_AO + I_OUT + I_F1 + I_F2;
    for (int it = gw; it < NITEMS; it += NGW) {
        int r = it;
        if (r < I_IN) { p0_transpose_item(F.w_in, 1024, NZ, F.WIN, 0, scr, r, F.lane); continue; } r -= I_IN;
        if (r < I_HO) { p0_transpose_item(F.w_ho, 512, 1024, F.WHO, 0, scr, r, F.lane); continue; } r -= I_HO;
        if (r < I_AO) { p0_transpose_item(F.w_ao, 512, 1024, F.WAO, 0, scr, r, F.lane); continue; } r -= I_AO;
        if (r < I_OUT) { p0_transpose_item(F.w_out, 1024, 1024, F.WOUT, 0, scr, r, F.lane); continue; } r -= I_OUT;
        if (r < I_F1) { p0_transpose_item(F.w_ff1, 1024, FFD, F.WF1, 0, scr, r, F.lane); continue; } r -= I_F1;
        p0_transpose_item(F.w_ff2, FFD, 1024, F.WF2, 0, scr, r, F.lane);
    }
    for (int i = blockIdx.x * (NWAVES * 64) + F.tid; i < 2 * 65536; i += F.G * NWAVES * 64) {
        const int which = i >> 16, ii = i & 65535, b = ii >> 13, t = (ii >> 4) & 511, chn = ii & 15;
        const float* src = (which ? F.cache_v : F.cache_k) + (size_t)ii * 8;
        const f32x4 a = *(const f32x4*)src, bq = *(const f32x4*)(src + 4);
        v4u o; o.x = pk2(a.x, a.y); o.y = pk2(a.z, a.w); o.z = pk2(bq.x, bq.y); o.w = pk2(bq.z, bq.w);
        *(v4u*)((which ? F.VL : F.KL) + ((size_t)b * 1536 + t) * 128 + chn * 8) = o;
    }
}
__device__ __forceinline__ void norm_mod_rows(Frame& F, const float* src_lo, const float* src_hi, bf16* dst, const float* nw, int sh_off, int sc_off) {
    const int gw = F.vcu * NWAVES + F.wave, NGW = F.G * NWAVES;
    for (int m0 = gw * 8; m0 < MROWS; m0 += NGW * 8) {
        const int req = m0 < MCTX ? 0 : 1 + ((m0 - MCTX) >> 10);
        const float* modr = F.MOD + (size_t)req * 6144;
        f32x4 gvec[4], svec[4];
#pragma unroll
        for (int j = 0; j < 4; ++j) { const int col = 4 * F.lane + 256 * j; const f32x4 w = *(const f32x4*)(nw + col), sc = *(const f32x4*)(modr + sc_off + col); gvec[j] = w * (sc + 1.0f); svec[j] = *(const f32x4*)(modr + sh_off + col); }
        for (int rr = 0; rr < 8; ++rr) { const int m = m0 + rr;
            const float* xrow = m < MCTX ? src_lo + (size_t)m * 1024 : src_hi + (size_t)(m - MCTX) * 1024;
            const f32x4* xr = (const f32x4*)xrow + F.lane;
            f32x4 v[4]; float s = 0.f;
#pragma unroll
            for (int j = 0; j < 4; ++j) { v[j] = xr[64 * j]; s += (v[j].x * v[j].x + v[j].y * v[j].y) + (v[j].z * v[j].z + v[j].w * v[j].w); }
            const float rstd = 1.0f / sqrtf(wave_sum(s) * (1.f / 1024.f) + EPSN);
            unsigned long long* o8 = (unsigned long long*)(dst + (size_t)m * 1024) + F.lane;
#pragma unroll
            for (int j = 0; j < 4; ++j) { const f32x4 y = v[j] * rstd * gvec[j] + svec[j]; o8[64 * j] = (unsigned long long)pk2(y.x, y.y) | ((unsigned long long)pk2(y.z, y.w) << 32); }
        }
    }
}
__device__ __forceinline__ void p3_qk(Frame& F) {
    const int gw = F.vcu * NWAVES + F.wave, NGW = F.G * NWAVES, l = F.lane, sub = l & 7;
    float qw[8], kw[8];
#pragma unroll
    for (int e = 0; e < 8; ++e) { qw[e] = F.q_norm_w[8 * sub + e]; kw[e] = F.k_norm_w[8 * sub + e]; }
    for (int m0 = gw * 8; m0 < MROWS; m0 += NGW * 8) {
        for (int rr = 0; rr < 8; ++rr) { const int row = m0 + rr;
            const bool latent = row >= MCTX; const int t = latent ? ((row - MCTX) & 1023) : (row & 255); const int b = latent ? ((row - MCTX) >> 10) : (row >> 8);
            bf16* zr = F.ZA + (size_t)row * ZA_LD;
            const v4u qraw = *(const v4u*)(zr + 8 * l);
            v4u kvraw = (v4u){0u, 0u, 0u, 0u}; if (l < 32) kvraw = *(const v4u*)(zr + 512 + 8 * l);
            float cs[8], sn[8];
            if (latent) { const int pos = (sub < 4) ? (t >> 6) : (t & 63); const float* tp = F.ROPE + 2 * (pos * 16 + 8 * (sub & 1));
#pragma unroll
                for (int e = 0; e < 8; e += 2) { const f32x4 w = *(const f32x4*)(tp + 2 * e); cs[e] = w.x; sn[e] = w.y; cs[e + 1] = w.z; sn[e + 1] = w.w; } }
            else {
#pragma unroll
                for (int e = 0; e < 8; ++e) { cs[e] = 1.f; sn[e] = 0.f; } }
            float q[8] = {bflo(qraw.x), bfhi(qraw.x), bflo(qraw.y), bfhi(qraw.y), bflo(qraw.z), bfhi(qraw.z), bflo(qraw.w), bfhi(qraw.w)};
            float ss = 0.f;
#pragma unroll
            for (int e = 0; e < 8; ++e) ss += q[e] * q[e];
            ss += __shfl_xor(ss, 1); ss += __shfl_xor(ss, 2); ss += __shfl_xor(ss, 4);
            float rstd = 1.0f / sqrtf(ss * (1.f / 64.f) + EPSN);
#pragma unroll
            for (int e = 0; e < 8; ++e) { q[e] = q[e] * rstd * qw[e]; }
            if (latent) {
#pragma unroll
                for (int e = 0; e < 8; ++e) { const float pr = __shfl_xor(q[e], 2); q[e] = (sub & 2) ? (q[e] * cs[e] + pr * sn[e]) : (q[e] * cs[e] - pr * sn[e]); } }
            { v4u o; o.x = pk2(q[0] * ATT_C2, q[1] * ATT_C2); o.y = pk2(q[2] * ATT_C2, q[3] * ATT_C2); o.z = pk2(q[4] * ATT_C2, q[5] * ATT_C2); o.w = pk2(q[6] * ATT_C2, q[7] * ATT_C2); *(v4u*)(zr + 8 * l) = o; }
            float k[8] = {bflo(kvraw.x), bfhi(kvraw.x), bflo(kvraw.y), bfhi(kvraw.y), bflo(kvraw.z), bfhi(kvraw.z), bflo(kvraw.w), bfhi(kvraw.w)};
            float ks = 0.f;
#pragma unroll
            for (int e = 0; e < 8; ++e) ks += k[e] * k[e];
            ks += __shfl_xor(ks, 1); ks += __shfl_xor(ks, 2); ks += __shfl_xor(ks, 4);
            rstd = 1.0f / sqrtf(ks * (1.f / 64.f) + EPSN);
            float kn[8];
#pragma unroll
            for (int e = 0; e < 8; ++e) kn[e] = k[e] * rstd * kw[e];
            if (!latent) {
                if (l < 16) { float* op = F.out + OUT_CK + (size_t)row * 128 + 8 * l; *(f32x4*)op = (f32x4){kn[0], kn[1], kn[2], kn[3]}; *(f32x4*)(op + 4) = (f32x4){kn[4], kn[5], kn[6], kn[7]}; }
                else if (l < 32) { float* op = F.out + OUT_CV + (size_t)row * 128 + 8 * (l - 16); *(f32x4*)op = (f32x4){k[0], k[1], k[2], k[3]}; *(f32x4*)(op + 4) = (f32x4){k[4], k[5], k[6], k[7]}; }
            } else {
#pragma unroll
                for (int e = 0; e < 8; ++e) { const float pr = __shfl_xor(kn[e], 2); kn[e] = (sub & 2) ? (kn[e] * cs[e] + pr * sn[e]) : (kn[e] * cs[e] - pr * sn[e]); } }
            bf16* kdst = latent ? F.KL + ((size_t)b * 1536 + 512 + t) * 128 : F.KC + (size_t)row * 128;
            bf16* vdst = latent ? F.VL + ((size_t)b * 1536 + 512 + t) * 128 : F.VC + (size_t)row * 128;
            if (l < 16) { v4u o; o.x = pk2(kn[0], kn[1]); o.y = pk2(kn[2], kn[3]); o.z = pk2(kn[4], kn[5]); o.w = pk2(kn[6], kn[7]); *(v4u*)(kdst + 8 * l) = o; }
            else if (l < 32) { *(v4u*)(vdst + 8 * (l - 16)) = kvraw; }
        }
    }
}
__device__ __forceinline__ void p5_combine(Frame& F) {
    const int gw = F.vcu * NWAVES + F.wave, NGW = F.G * NWAVES, l = F.lane;
    float wn[8];
#pragma unroll
    for (int e = 0; e < 8; ++e) wn[e] = F.hgrn_norm_w[8 * (l & 15) + e];
    const float* od0 = F.out + OUT_Y; const float* od1 = od0 + (size_t)MROWS * 512;
    for (int m = gw; m < MROWS; m += NGW) {
        const float* a = od0 + (size_t)m * 512 + 8 * l; const float* bq = od1 + (size_t)m * 512 + 8 * l;
        const f32x4 a0 = *(const f32x4*)a, a1 = *(const f32x4*)(a + 4), b0 = *(const f32x4*)bq, b1 = *(const f32x4*)(bq + 4);
        bf16* zr = F.ZH + (size_t)m * ZH_LD;
        const v4u graw = *(const v4u*)(zr + 2048 + 8 * l);
        float o[8] = {a0.x + b0.x, a0.y + b0.y, a0.z + b0.z, a0.w + b0.w, a1.x + b1.x, a1.y + b1.y, a1.z + b1.z, a1.w + b1.w};
        float ss = 0.f;
#pragma unroll
        for (int e = 0; e < 8; ++e) ss += o[e] * o[e];
        ss += __shfl_xor(ss, 1); ss += __shfl_xor(ss, 2); ss += __shfl_xor(ss, 4); ss += __shfl_xor(ss, 8);
        const float rstd = 1.0f / sqrtf(ss * (1.f / 128.f) + EPSN);
        const float hgv[8] = {bflo(graw.x), bfhi(graw.x), bflo(graw.y), bfhi(graw.y), bflo(graw.z), bfhi(graw.z), bflo(graw.w), bfhi(graw.w)};
        float y[8];
#pragma unroll
        for (int e = 0; e < 8; ++e) y[e] = o[e] * rstd * wn[e] * hgv[e] * sigmf(hgv[e]);
        v4u w; w.x = pk2(y[0], y[1]); w.y = pk2(y[2], y[3]); w.z = pk2(y[4], y[5]); w.w = pk2(y[6], y[7]);
        *(v4u*)(zr + 8 * l) = w;
    }
}
__device__ __forceinline__ void p11_final(Frame& F) {
    const int gw = F.vcu * NWAVES + F.wave, NGW = F.G * NWAVES;
    f32x4 wv[4];
#pragma unroll
    for (int j = 0; j < 4; ++j) wv[j] = *(const f32x4*)(F.final_w + 4 * F.lane + 256 * j);
    for (int m = gw; m < MROWS; m += NGW) {
        f32x4* xr = (f32x4*)(F.out + OUT_Y + (size_t)m * 1024) + F.lane;
        f32x4 v[4]; float s = 0.f;
#pragma unroll
        for (int j = 0; j < 4; ++j) { v[j] = xr[64 * j]; s += (v[j].x * v[j].x + v[j].y * v[j].y) + (v[j].z * v[j].z + v[j].w * v[j].w); }
        const float rstd = 1.0f / sqrtf(wave_sum(s) * (1.f / 1024.f) + EPSN);
#pragma unroll
        for (int j = 0; j < 4; ++j) xr[64 * j] = v[j] * rstd * wv[j];
    }
}
constexpr int MIX_HL = 64, MIX_HC = 256, MIX_H = MIX_HL + MIX_HC, MIX_AL = 256, MIX_AC = 256, MIX_A = MIX_AL + MIX_AC;
__device__ __forceinline__ void p4_hgrn_item(Frame& F, int it) {
    float* odir = F.out + OUT_Y;
    if (it < MIX_HL) { const int b = it >> 3, h = (it >> 1) & 3, dir = it & 1;
        hg::hgrn_unit(F.lds + RING_OFF, F.ZH, odir, MCTX + b * 1024, 1024, h, dir, F.state + (size_t)((b * 2 + dir) * 4 + h) * 16384, nullptr, F.lb_logits);
    } else { const int u = it - MIX_HL, b = u >> 3, h = (u >> 1) & 3, dir = u & 1;
        hg::hgrn_unit(F.lds + RING_OFF, F.ZH, odir, b * 256, 256, h, dir, nullptr, F.out + OUT_ST + (size_t)((b * 2 + dir) * 4 + h) * 16384, F.lb_logits);
    }
}
__device__ __forceinline__ void p4_attn_item(Frame& F, unsigned char* lds_generic, int it, bool scratch_out) {
    if (it < MIX_AL) { const int u = it, b = u >> 5, head = (u >> 2) & 7, qb = u & 3;
        bf16* q = F.ZA + (size_t)(MCTX + b * 1024 + qb * 256) * ZA_LD + head * 64;
        attn_body::attn_unit<8, 24>(q, F.KL + (size_t)b * 1536 * 128 + (head >> 2) * 64, F.VL + (size_t)b * 1536 * 128 + (head >> 2) * 64, scratch_out ? F.XN + (q - F.ZA) : q, (char*)lds_generic + RING_OFF);
    } else { const int u = it - MIX_AL, b = u >> 3, head = u & 7;
        bf16* q = F.ZA + (size_t)(b * 256) * ZA_LD + head * 64;
        attn_body::attn_unit<8, 4>(q, F.KC + (size_t)b * 256 * 128 + (head >> 2) * 64, F.VC + (size_t)b * 256 * 128 + (head >> 2) * 64, scratch_out ? F.XN + (q - F.ZA) : q, (char*)lds_generic + RING_OFF);
    }
}
#ifndef MK_REP0
#define MK_REP0 1
#endif
#ifndef MK_REP1
#define MK_REP1 1
#endif
#ifndef MK_REP2
#define MK_REP2 1
#endif
#ifndef MK_REP4H
#define MK_REP4H 1
#endif
#ifndef MK_REP4A
#define MK_REP4A 1
#endif
#ifndef MK_REP5
#define MK_REP5 1
#endif
#ifndef MK_REP7
#define MK_REP7 1
#endif
#ifndef MK_REP8
#define MK_REP8 1
#endif
#ifndef MK_REP9
#define MK_REP9 1
#endif
#ifndef MK_REPBAR
#define MK_REPBAR 0
#endif
struct Args { const float* in[22]; float* out; unsigned char* ws; int ph_lo, ph_hi; };
__global__ void __launch_bounds__(NWAVES * 64, 2) mk_fwd(Args args) {
    extern __shared__ __attribute__((aligned(16))) unsigned char lds[];
    Frame F;
    F.lds = (LAS unsigned char*)lds;
    F.MISC = (volatile LAS unsigned*)(F.lds + MISC_OFF);
    F.tid = threadIdx.x; F.lane = F.tid & 63; F.wave = __builtin_amdgcn_readfirstlane(F.tid >> 6);
    F.G = gridDim.x; { const int bx = blockIdx.x; F.vcu = (F.G % 8 == 0) ? (bx % 8) * (F.G / 8) + bx / 8 : bx; }
    unsigned char* ws = args.ws;
    F.ctl = (gu32*)(ws + WS_CTL);
    F.x_prompt = args.in[0]; F.x_sample = args.in[1]; F.cache_k = args.in[2]; F.cache_v = args.in[3]; F.state = args.in[4]; F.c = args.in[5]; F.c_ctx = args.in[6];
    F.w_ada = args.in[7]; F.b_ada = args.in[8]; F.norm_mix_w = args.in[9]; F.w_in = args.in[10]; F.q_norm_w = args.in[11]; F.k_norm_w = args.in[12]; F.lb_logits = args.in[13];
    F.hgrn_norm_w = args.in[14]; F.w_ho = args.in[15]; F.w_ao = args.in[16]; F.w_out = args.in[17]; F.norm_ffn_w = args.in[18]; F.w_ff1 = args.in[19]; F.w_ff2 = args.in[20]; F.final_w = args.in[21];
    F.out = args.out;
    F.MOD = (float*)(ws + WS_MOD); F.ROPE = (float*)(ws + WS_ROPE);
    F.WIN = (bf16*)(ws + WS_WIN); F.WHO = (bf16*)(ws + WS_WHO); F.WAO = (bf16*)(ws + WS_WAO); F.WOUT = (bf16*)(ws + WS_WOUT); F.WF1 = (bf16*)(ws + WS_WF1); F.WF2 = (bf16*)(ws + WS_WF2);
    F.KC = (bf16*)(ws + WS_KC); F.VC = (bf16*)(ws + WS_VC); F.KL = (bf16*)(ws + WS_KL); F.VL = (bf16*)(ws + WS_VL);
    F.XN = (bf16*)(ws + WS_XN); F.ZH = (bf16*)(ws + WS_ZH); F.ZA = (bf16*)(ws + WS_ZA); F.ZG = (bf16*)(ws + WS_ZG); F.HB = (bf16*)(ws + WS_HB);
    for (int u = F.tid; u < (LDS_BYTES - LDSCTL_OFF) / 4; u += NWAVES * 64) ((LAS unsigned*)(F.lds + LDSCTL_OFF))[u] = 0u;
    __syncthreads();
    XcdBarrier bar; bar.bar = (unsigned*)(F.ctl + CW_BAR); bar.x = 0; bar.st = nullptr;
    if (N_LAUNCHES == 1) bar = xcd_barrier_post((unsigned*)(F.ctl + CW_BAR), F.MISC + 8);
#define GRID_BAR() do { if (N_LAUNCHES == 1) xcd_barrier(bar); } while (0)
    const int lo = args.ph_lo, hi = args.ph_hi;
#define IN(k) (lo <= (k) && (k) < hi)
#define BOTH(k) (IN(k) && IN((k) + 1))

    if (IN(0)) { for (int rep = 0; rep < MK_REP0; ++rep) { p0_prologue(F); if (BOTH(0)) GRID_BAR(); } for (int rep = 0; rep < MK_REPBAR; ++rep) GRID_BAR(); }
    if (IN(1)) { for (int rep = 0; rep < MK_REP1; ++rep) { norm_mod_rows(F, F.x_prompt, F.x_sample, F.XN, F.norm_mix_w, 0, 1024); if (BOTH(1)) GRID_BAR(); } }
    if (IN(2)) for (int rep = 0; rep < MK_REP2; ++rep) {
        pg8::Gemm g{F.XN, F.WIN, MROWS, NZ, 1024, 1024}; pg8::StaticOrder S; S.init(MROWS, NZ, F.G, (int)blockIdx.x);
        pg8::EpiZ E{F.ZH, F.ZA, F.ZG};
        pg8::gemm_phase<pg8::EpiZ, pg8::StaticOrder, PG8_ALIGN, PG8_SP2>(F.lds + RING_OFF, g, S, E);
        if (BOTH(2)) GRID_BAR();
    }
    if (IN(3)) { p3_qk(F); if (BOTH(3)) GRID_BAR(); }
    if (IN(4)) {
        for (int rep = 0; rep < MK_REP4H; ++rep)
        for (int it = (int)blockIdx.x; it < MIX_H; ) {
            p4_hgrn_item(F, it);
            if (F.tid == 0) F.MISC[4] = (unsigned)F.G + __hip_atomic_fetch_add((unsigned*)(F.ctl + CW_QUEUE + 128 * rep), 1u, __ATOMIC_RELAXED, __HIP_MEMORY_SCOPE_AGENT);
            __syncthreads();
            it = (int)F.MISC[4];
            __syncthreads();
        }
        for (int rep = MK_REP4A - 1; rep >= 0; --rep)
        for (;;) {
            if (F.tid == 0) F.MISC[5] = __hip_atomic_fetch_add((unsigned*)(F.ctl + CW_QUEUE + 64 + 128 * rep), 1u, __ATOMIC_RELAXED, __HIP_MEMORY_SCOPE_AGENT);
            __syncthreads();
            const int it = (int)F.MISC[5];
            __syncthreads();
            if (it >= MIX_A) break;
            p4_attn_item(F, lds, it, rep > 0);
        }
        if (BOTH(4)) GRID_BAR();
    }
    if (IN(5)) for (int rep = 0; rep < MK_REP5; ++rep) {
        p5_combine(F);
        pg8::Gemm g{F.ZA, F.WAO, MROWS, 1024, 512, ZA_LD}; pg8::StaticOrder S; S.init(MROWS, 1024, F.G, (int)blockIdx.x);
        pg8::EpiGate<false> E{F.ZG + 1024, ZG_LD, F.XN, 1024};
        pg8::gemm_phase<pg8::EpiGate<false>, pg8::StaticOrder, PG8_ALIGN, PG8_SP2>(F.lds + RING_OFF, g, S, E);
        if (BOTH(5)) GRID_BAR();
    }
    if (IN(6)) {
        pg8::Gemm g{F.ZH, F.WHO, MROWS, 1024, 512, ZH_LD}; pg8::StaticOrder S; S.init(MROWS, 1024, F.G, (int)blockIdx.x);
        pg8::EpiGate<true> E{F.ZG, ZG_LD, F.XN, 1024};
        pg8::gemm_phase<pg8::EpiGate<true>, pg8::StaticOrder, PG8_ALIGN, PG8_SP2>(F.lds + RING_OFF, g, S, E);
        if (BOTH(6)) GRID_BAR();
    }
    if (IN(7)) for (int rep = 0; rep < MK_REP7; ++rep) {
        pg8::Gemm g{F.XN, F.WOUT, MROWS, 1024, 1024, 1024}; pg8::StaticOrder S; S.init(MROWS, 1024, F.G, (int)blockIdx.x);
        pg8::EpiResid E{F.x_prompt, F.x_sample, F.out + OUT_Y, F.MOD + 2048};
        pg8::gemm_phase<pg8::EpiResid, pg8::StaticOrder, PG8_ALIGN, PG8_SP2>(F.lds + RING_OFF, g, S, E);
        if (BOTH(7)) GRID_BAR();
    }
    if (IN(8)) { for (int rep = 0; rep < MK_REP8; ++rep) { norm_mod_rows(F, F.out + OUT_Y, F.out + OUT_Y + (size_t)MCTX * 1024, F.XN, F.norm_ffn_w, 3072, 4096); if (BOTH(8)) GRID_BAR(); } }
    if (IN(9)) for (int rep = 0; rep < MK_REP9; ++rep) {
        pg8::Gemm g{F.XN, F.WF1, MROWS, FFD, 1024, 1024}; pg8::StaticOrder S; S.init(MROWS, FFD, F.G, (int)blockIdx.x);
        pg8::EpiRelu2 E{F.HB, FFD};
        pg8::gemm_phase<pg8::EpiRelu2, pg8::StaticOrder, PG8_ALIGN, PG8_SP2>(F.lds + RING_OFF, g, S, E);
        if (BOTH(9)) GRID_BAR();
    }
    if (IN(10)) {
        pg8::Gemm g{F.HB, F.WF2, MROWS, 1024, FFD, FFD}; pg8::StaticOrder S; S.init(MROWS, 1024, F.G, (int)blockIdx.x);
        pg8::EpiResid E{F.out + OUT_Y, F.out + OUT_Y + (size_t)MCTX * 1024, F.out + OUT_Y, F.MOD + 5120};
        pg8::gemm_phase<pg8::EpiResid, pg8::StaticOrder, PG8_ALIGN, PG8_SP2>(F.lds + RING_OFF, g, S, E);
        if (BOTH(10)) GRID_BAR();
    }
    if (IN(11)) { p11_final(F); }
#undef IN
#undef BOTH
#undef GRID_BAR
}

extern "C" void kernel_launch(void* const* d_in, const int* in_sizes, int n_in, void* d_out, int out_size, void* d_ws, size_t ws_size, hipStream_t stream) {
    static int grid = 0;
    if (grid == 0) {
        if (n_in != 22 || out_size != (int)OUT_TOTAL || ws_size < WS_END) { fprintf(stderr, "kernel_launch: unexpected shapes: n_in %d out %d ws %zu; nothing launched\n", n_in, out_size, ws_size); grid = -1; return; }
        int dev = 0, cus = 0, per_cu = 0;
        if (hipGetDevice(&dev) != hipSuccess || hipDeviceGetAttribute(&cus, hipDeviceAttributeMultiprocessorCount, dev) != hipSuccess) { fprintf(stderr, "kernel_launch: device query failed\n"); grid = -1; return; }
        if (hipFuncSetAttribute((const void*)mk_fwd, hipFuncAttributeMaxDynamicSharedMemorySize, LDS_BYTES) != hipSuccess) { fprintf(stderr, "kernel_launch: hipFuncSetAttribute failed\n"); grid = -1; return; }
        if (hipOccupancyMaxActiveBlocksPerMultiprocessor(&per_cu, (const void*)mk_fwd, NWAVES * 64, LDS_BYTES) != hipSuccess || per_cu < 1) { fprintf(stderr, "kernel_launch: occupancy query reports %d workgroups per CU\n", per_cu); (void)hipGetLastError(); grid = -1; return; }
        grid = cus;
        if (grid > 256) grid = 256;
    }
    if (grid < 0) return;
    if (hipMemsetAsync((char*)d_ws + WS_CTL, 0, CTL_ZERO_BYTES, stream) != hipSuccess) { fprintf(stderr, "kernel_launch: hipMemsetAsync failed\n"); return; }
    Args a{};
    for (int i = 0; i < 22; ++i) a.in[i] = (const float*)d_in[i];
    a.out = (float*)d_out; a.ws = (unsigned char*)d_ws;
    for (int li = 0; li < N_LAUNCHES; ++li) {
        a.ph_lo = (N_LAUNCHES == 1) ? 0 : li; a.ph_hi = (N_LAUNCHES == 1) ? NPH : li + 1;
        hipLaunchKernelGGL(mk_fwd, dim3(grid), dim3(NWAVES * 64), LDS_BYTES, stream, a);
        const hipError_t le = hipPeekAtLastError();
        if (le != hipSuccess) { fprintf(stderr, "kernel_launch: launch %d failed: %s\n", li, hipGetErrorName(le)); break; }
    }
}
```

```cpp
#include <hip/hip_runtime.h>
#include <cstdio>
#include <cstdint>
namespace pg8 {
#define PG8_LAS __attribute__((address_space(3)))
typedef unsigned short bf16_t;
typedef short bf16x8 __attribute__((ext_vector_type(8)));
typedef float f32x4 __attribute__((ext_vector_type(4)));
typedef unsigned u32x4 __attribute__((ext_vector_type(4)));
constexpr int BM = 256, BK = 64, HALF = 128, HTB = HALF * BK * 2  , STAGE_BYTES = 8 * HTB, NXCD = 8, WGM = 8;

__host__ __device__ __forceinline__ int lds_byte(int r, int c) { const int st = (r >> 4) * 2 + (c >> 5), rr = r & 15, cc = c & 31, ob = rr * 64 + cc * 2; return st * 1024 + (ob ^ (((ob >> 9) & 1) << 5)); }
__host__ __device__ __forceinline__ void stage_rc(int b, int& R, int& C) { const int st = b / 1024, sb = b % 1024, swz = sb ^ (((sb >> 9) & 1) << 5); R = (st >> 1) * 16 + swz / 64; C = (st & 1) * 32 + (swz % 64) / 2; }
__host__ __device__ __forceinline__ int perm32(int rho) { const int n = rho >> 4, i = rho & 15; return 8 * (i >> 2) + 4 * n + (i & 3); }

struct Unit { int pm, pn; };
struct Gemm { const bf16_t* A; const bf16_t* Bt; int M, N, K, lda; };

struct StaticOrder {
    int nM, nN, nwg, G, c;
    __host__ __device__ void init(int M, int N, int G_, int c_) { nM = M / BM; nN = N / BM; nwg = nM * nN; G = G_; c = c_; }
    __host__ __device__ bool next(int i, Unit& u) const {
        const long L = (long)i * G + c; if (L >= nwg) return false;
        int wgid = (int)L; { const int q = nwg / NXCD, r = nwg % NXCD, xcd = wgid % NXCD, off = wgid / NXCD; wgid = (xcd < r ? xcd * (q + 1) : r * (q + 1) + (xcd - r) * q) + off; }
        const int nig = WGM * nN, gid = wgid / nig, fm = gid * WGM, gsz = (nM - fm) < WGM ? (nM - fm) : WGM;
        u.pm = fm + ((wgid % nig) % gsz); u.pn = (wgid % nig) / gsz; return true;
    }
    __device__ __forceinline__ void a_ready(const Unit&) const {}
    __device__ __forceinline__ void done(const Unit&) const {}
};
__device__ __forceinline__ unsigned cvt_pk_bf16(float lo, float hi) { unsigned r; asm volatile("v_cvt_pk_bf16_f32 %0, %1, %2" : "=v"(r) : "v"(lo), "v"(hi)); return r; }
__device__ __forceinline__ float bf_lo(unsigned w) { return __uint_as_float(w << 16); }
__device__ __forceinline__ float bf_hi(unsigned w) { return __uint_as_float(w & 0xffff0000u); }
__device__ __forceinline__ float sigm(float x) { return __builtin_amdgcn_rcpf(1.0f + __builtin_amdgcn_exp2f(-1.4426950408889634f * x)); }

struct EpiZ {
    static constexpr bool PERM = true, AFTER_DRAIN = false;
    bf16_t *ZH, *ZA, *ZG;
    __device__ __forceinline__ void operator()(const f32x4 (&acc)[2][2][4][2], const Unit& u, int wr, int wc, int fr, int fq) const {
        const int row0 = u.pm * BM + wr * 64 + fr; bf16_t* base; int ld, colt;
        if (u.pn < 10) { base = ZH; ld = 2560; colt = u.pn * BM; } else if (u.pn < 13) { base = ZA; ld = 768; colt = (u.pn - 10) * BM; } else { base = ZG; ld = 2048; colt = (u.pn - 13) * BM; }
        const int col0 = colt + wc * 32 + 8 * fq;
#pragma unroll
        for (int ai = 0; ai < 2; ++ai)
#pragma unroll
            for (int m = 0; m < 4; ++m) { bf16_t* rowp = base + (size_t)(row0 + ai * HALF + m * 16) * ld + col0;
#pragma unroll
                for (int bj = 0; bj < 2; ++bj) { const f32x4 v0 = acc[ai][bj][m][0], v1 = acc[ai][bj][m][1];
                    u32x4 w; w.x = cvt_pk_bf16(v0[0], v0[1]); w.y = cvt_pk_bf16(v0[2], v0[3]); w.z = cvt_pk_bf16(v1[0], v1[1]); w.w = cvt_pk_bf16(v1[2], v1[3]);
                    *(u32x4*)(rowp + bj * HALF) = w; } }
    }
};
template <bool HAS_ADD> struct EpiGate {
    static constexpr bool PERM = true, AFTER_DRAIN = false;
    const bf16_t* G; int ldg; bf16_t* O; int ldo;
    __device__ __forceinline__ void operator()(const f32x4 (&acc)[2][2][4][2], const Unit& u, int wr, int wc, int fr, int fq) const {
        const int row0 = u.pm * BM + wr * 64 + fr, col0 = u.pn * BM + wc * 32 + 8 * fq;
#pragma unroll
        for (int ai = 0; ai < 2; ++ai)
#pragma unroll
            for (int m = 0; m < 4; ++m) { const size_t row = (size_t)(row0 + ai * HALF + m * 16);
#pragma unroll
                for (int bj = 0; bj < 2; ++bj) { const f32x4 v0 = acc[ai][bj][m][0], v1 = acc[ai][bj][m][1];
                    const u32x4 gw = *(const u32x4*)(G + row * ldg + col0 + bj * HALF);
                    float r0 = v0[0] * sigm(bf_lo(gw.x)), r1 = v0[1] * sigm(bf_hi(gw.x)), r2 = v0[2] * sigm(bf_lo(gw.y)), r3 = v0[3] * sigm(bf_hi(gw.y));
                    float r4 = v1[0] * sigm(bf_lo(gw.z)), r5 = v1[1] * sigm(bf_hi(gw.z)), r6 = v1[2] * sigm(bf_lo(gw.w)), r7 = v1[3] * sigm(bf_hi(gw.w));
                    bf16_t* op = O + row * ldo + col0 + bj * HALF;
                    if (HAS_ADD) { const u32x4 aw = *(const u32x4*)op;
                        r0 += bf_lo(aw.x); r1 += bf_hi(aw.x); r2 += bf_lo(aw.y); r3 += bf_hi(aw.y); r4 += bf_lo(aw.z); r5 += bf_hi(aw.z); r6 += bf_lo(aw.w); r7 += bf_hi(aw.w); }
                    u32x4 w; w.x = cvt_pk_bf16(r0, r1); w.y = cvt_pk_bf16(r2, r3); w.z = cvt_pk_bf16(r4, r5); w.w = cvt_pk_bf16(r6, r7);
                    *(u32x4*)op = w; } }
    }
};
struct EpiResid {
    static constexpr bool PERM = false, AFTER_DRAIN = false;
    const float* base_lo; const float* base_hi; float* out; const float* gate;
    __device__ __forceinline__ void operator()(const f32x4 (&acc)[2][2][4][2], const Unit& u, int wr, int wc, int fr, int fq) const {
        const int col0 = u.pn * BM + wc * 32 + 4 * fq;
        const int req = u.pm < 32 ? 0 : 1 + ((u.pm - 32) >> 2);
        const float* bs = u.pm < 32 ? base_lo : base_hi - (size_t)8192 * 1024;
        f32x4 gv[2][2];
#pragma unroll
        for (int bj = 0; bj < 2; ++bj)
#pragma unroll
            for (int n = 0; n < 2; ++n) gv[bj][n] = *(const f32x4*)(gate + (size_t)req * 6144 + col0 + bj * HALF + n * 16);
#pragma unroll
        for (int ai = 0; ai < 2; ++ai)
#pragma unroll
            for (int m = 0; m < 4; ++m) { const size_t off = (size_t)(u.pm * BM + ai * HALF + wr * 64 + m * 16 + fr) * 1024 + col0;
#pragma unroll
                for (int bj = 0; bj < 2; ++bj)
#pragma unroll
                    for (int n = 0; n < 2; ++n) { const f32x4 b = *(const f32x4*)(bs + off + bj * HALF + n * 16);
                        *(f32x4*)(out + off + bj * HALF + n * 16) = b + gv[bj][n] * acc[ai][bj][m][n]; } }
    }
};
struct EpiRelu2 {
    static constexpr bool PERM = true, AFTER_DRAIN = false;
    bf16_t* O; int ldc;
    __device__ __forceinline__ void operator()(const f32x4 (&acc)[2][2][4][2], const Unit& u, int wr, int wc, int fr, int fq) const {
        const int row0 = u.pm * BM + wr * 64 + fr, col0 = u.pn * BM + wc * 32 + 8 * fq;
#pragma unroll
        for (int ai = 0; ai < 2; ++ai)
#pragma unroll
            for (int m = 0; m < 4; ++m) { bf16_t* rowp = O + (size_t)(row0 + ai * HALF + m * 16) * ldc + col0;
#pragma unroll
                for (int bj = 0; bj < 2; ++bj) { f32x4 v0 = acc[ai][bj][m][0], v1 = acc[ai][bj][m][1];
#pragma unroll
                    for (int e = 0; e < 4; ++e) { const float a = fmaxf(v0[e], 0.f), b = fmaxf(v1[e], 0.f); v0[e] = a * a; v1[e] = b * b; }
                    u32x4 w; w.x = cvt_pk_bf16(v0[0], v0[1]); w.y = cvt_pk_bf16(v0[2], v0[3]); w.z = cvt_pk_bf16(v1[0], v1[1]); w.w = cvt_pk_bf16(v1[2], v1[3]);
                    *(u32x4*)(rowp + bj * HALF) = w; } }
    }
};

template <class Epi, class Sched, bool ALIGN_EPI = false, bool SP2 = false>
__device__ __forceinline__ void gemm_phase(PG8_LAS unsigned char* lds, const Gemm g, const Sched& S, const Epi& E) {
    const int tid = threadIdx.x, wid = __builtin_amdgcn_readfirstlane(tid >> 6), lane = tid & 63, wr = wid >> 2, wc = wid & 3, fr = lane & 15, fq = lane >> 4;
    const int K = g.K, nt = K / BK;
    unsigned voffA[2], voffB[2];
#pragma unroll
    for (int i = 0; i < 2; ++i) { int R, C; stage_rc(tid * 16 + i * 8192, R, C); const int Rb = Epi::PERM ? ((R & ~31) + perm32(R & 31)) : R;
        voffA[i] = (unsigned)(R * g.lda + C) * 2u; voffB[i] = (unsigned)(Rb * K + C) * 2u; }
    const size_t kstep = (size_t)(BK * 2);
    const size_t hsA = (size_t)HALF * g.lda * 2, hsB = (size_t)HALF * K * 2;
    const size_t tsA = 2 * hsA, tsB = 2 * hsB;
    const unsigned ldsw = (unsigned)wid * 1024u;
    const int aoff = lds_byte(wr * 64 + fr, fq * 8), boff = lds_byte(wc * 32 + fr, fq * 8);
#define PG8_SA(b, h) (((b) * 2 + (h)) * HTB)
#define PG8_SB(b, h) ((4 + (b) * 2 + (h)) * HTB)
#define PG8_STAGE(bufoff, gbase, voff) do { _Pragma("unroll") for (int _i = 0; _i < 2; ++_i) \
        __builtin_amdgcn_global_load_lds((const unsigned*)((const char*)(gbase) + (voff)[_i]), (PG8_LAS unsigned*)(lds + (bufoff) + ldsw + _i * 8192), 16, 0, 0); } while (0)
#define PG8_LDA(dst, b, h) do { _Pragma("unroll") for (int m = 0; m < 4; ++m) _Pragma("unroll") for (int k = 0; k < 2; ++k) dst[m][k] = *(const PG8_LAS bf16x8*)(lds + PG8_SA(b, h) + aoff + m * 2048 + k * 1024); } while (0)
#define PG8_LDB(dst, b, h) do { _Pragma("unroll") for (int n = 0; n < 2; ++n) _Pragma("unroll") for (int k = 0; k < 2; ++k) dst[n][k] = *(const PG8_LAS bf16x8*)(lds + PG8_SB(b, h) + boff + n * 2048 + k * 1024); } while (0)
#define PG8_MMA(ai, bj, At, Bt) do { __builtin_amdgcn_s_setprio(1); _Pragma("unroll") for (int m = 0; m < 4; ++m) _Pragma("unroll") for (int n = 0; n < 2; ++n) _Pragma("unroll") for (int k = 0; k < 2; ++k) \
        acc[ai][bj][m][n] = __builtin_amdgcn_mfma_f32_16x16x32_bf16(Bt[n][k], At[m][k], acc[ai][bj][m][n], 0, 0, 0); __builtin_amdgcn_s_setprio(0); } while (0)
#define PG8_WAIT_V(n) asm volatile("s_waitcnt vmcnt(" #n ")" ::: "memory")
#define PG8_WAIT_L(n) asm volatile("s_waitcnt lgkmcnt(" #n ")" ::: "memory")
#define PG8_BAR __builtin_amdgcn_s_barrier()
#define PG8_SCHED __builtin_amdgcn_sched_barrier(0)
    Unit cur, nxt; int ui = 0;
    if (!S.next(0, cur)) return;
    f32x4 acc[2][2][4][2];
#pragma unroll
    for (int a = 0; a < 2; ++a)
#pragma unroll
        for (int b = 0; b < 2; ++b)
#pragma unroll
            for (int m = 0; m < 4; ++m)
#pragma unroll
                for (int n = 0; n < 2; ++n) acc[a][b][m][n] = (f32x4){0.f, 0.f, 0.f, 0.f};
    bf16x8 At[4][2], B0[2][2], B1[2][2];
    const char* cA = (const char*)g.A + (size_t)cur.pm * tsA; const char* cB = (const char*)g.Bt + (size_t)cur.pn * tsB;
    S.a_ready(cur);
    if constexpr (SP2) {
        PG8_STAGE(PG8_SB(0, 0), cB, voffB); PG8_STAGE(PG8_SB(0, 1), cB + hsB, voffB); PG8_STAGE(PG8_SA(0, 0), cA, voffA); PG8_STAGE(PG8_SA(0, 1), cA + hsA, voffA);
        if (wr == 1) PG8_BAR;
        PG8_WAIT_V(2); PG8_BAR;
        PG8_STAGE(PG8_SB(1, 0), cB + kstep, voffB); PG8_STAGE(PG8_SA(1, 0), cA + kstep, voffA); PG8_STAGE(PG8_SB(1, 1), cB + hsB + kstep, voffB);
        PG8_WAIT_V(6); PG8_BAR;
    } else {
        PG8_STAGE(PG8_SB(0, 0), cB, voffB); PG8_STAGE(PG8_SA(0, 0), cA, voffA); PG8_STAGE(PG8_SB(0, 1), cB + hsB, voffB); PG8_STAGE(PG8_SA(0, 1), cA + hsA, voffA);
        if (wr == 1) PG8_BAR;
        PG8_WAIT_V(4); PG8_BAR;
        PG8_STAGE(PG8_SB(1, 0), cB + kstep, voffB); PG8_STAGE(PG8_SA(1, 0), cA + kstep, voffA); PG8_STAGE(PG8_SB(1, 1), cB + hsB + kstep, voffB);
        PG8_WAIT_V(6); PG8_BAR;
    }
    for (;;) {
        const bool has_next = S.next(ui + 1, nxt);
        const char* nA = has_next ? (const char*)g.A + (size_t)nxt.pm * tsA : cA; const char* nB = has_next ? (const char*)g.Bt + (size_t)nxt.pn * tsB : cB;
        for (int t = 0; t < nt; t += 2) {
            const bool last = (t == nt - 2);
            const char* a1 = cA + (size_t)(t + 1) * kstep;
            const char* a2 = last ? nA : cA + (size_t)(t + 2) * kstep; const char* b2 = last ? nB : cB + (size_t)(t + 2) * kstep;
            const char* a3 = a2 + kstep; const char* b3 = b2 + kstep;
            if (last && has_next) S.a_ready(nxt);
            if constexpr (SP2) {
            PG8_LDB(B0, 0, 0); PG8_LDB(B1, 0, 1); PG8_SCHED; PG8_LDA(At, 0, 0); PG8_STAGE(PG8_SA(1, 1), a1 + hsA, voffA);
            PG8_WAIT_V(8); PG8_WAIT_L(0); PG8_BAR; PG8_MMA(0, 0, At, B0); PG8_MMA(0, 1, At, B1); PG8_BAR; PG8_SCHED;
            PG8_LDA(At, 0, 1); PG8_STAGE(PG8_SB(0, 0), b2, voffB); PG8_STAGE(PG8_SB(0, 1), b2 + hsB, voffB); PG8_STAGE(PG8_SA(0, 0), a2, voffA);
            PG8_WAIT_V(8); PG8_WAIT_L(0); PG8_BAR; PG8_MMA(1, 0, At, B0); PG8_MMA(1, 1, At, B1); PG8_BAR; PG8_SCHED;
            PG8_LDB(B0, 1, 0); PG8_LDB(B1, 1, 1); PG8_SCHED; PG8_LDA(At, 1, 0); PG8_STAGE(PG8_SA(0, 1), a2 + hsA, voffA);
            PG8_WAIT_V(8); PG8_WAIT_L(0); PG8_BAR; PG8_MMA(0, 0, At, B0); PG8_MMA(0, 1, At, B1); PG8_BAR; PG8_SCHED;
            PG8_LDA(At, 1, 1); PG8_STAGE(PG8_SB(1, 0), b3, voffB); PG8_STAGE(PG8_SB(1, 1), b3 + hsB, voffB); PG8_STAGE(PG8_SA(1, 0), a3, voffA);
            PG8_WAIT_V(8); PG8_WAIT_L(0); PG8_BAR; PG8_MMA(1, 0, At, B0); PG8_MMA(1, 1, At, B1); PG8_BAR; PG8_SCHED;
            } else {
            PG8_LDB(B0, 0, 0); PG8_SCHED; PG8_LDA(At, 0, 0); PG8_STAGE(PG8_SA(1, 1), a1 + hsA, voffA);
            PG8_WAIT_L(8); PG8_BAR; PG8_WAIT_L(0); PG8_MMA(0, 0, At, B0); PG8_BAR; PG8_SCHED;
            PG8_LDB(B1, 0, 1); PG8_STAGE(PG8_SB(0, 0), b2, voffB);
            PG8_BAR; PG8_WAIT_L(0); PG8_MMA(0, 1, At, B1); PG8_BAR;
            PG8_LDA(At, 0, 1); PG8_STAGE(PG8_SA(0, 0), a2, voffA);
            PG8_BAR; PG8_WAIT_L(0); PG8_MMA(1, 0, At, B0); PG8_BAR; PG8_SCHED;
            PG8_STAGE(PG8_SB(0, 1), b2 + hsB, voffB);
            PG8_WAIT_V(6); PG8_BAR; PG8_MMA(1, 1, At, B1); PG8_BAR;
            PG8_LDB(B0, 1, 0); PG8_SCHED; PG8_LDA(At, 1, 0); PG8_STAGE(PG8_SA(0, 1), a2 + hsA, voffA);
            PG8_WAIT_L(8); PG8_BAR; PG8_WAIT_L(0); PG8_MMA(0, 0, At, B0); PG8_BAR; PG8_SCHED;
            PG8_LDB(B1, 1, 1); PG8_STAGE(PG8_SB(1, 0), b3, voffB);
            PG8_BAR; PG8_WAIT_L(0); PG8_MMA(0, 1, At, B1); PG8_BAR;
            PG8_LDA(At, 1, 1); PG8_STAGE(PG8_SA(1, 0), a3, voffA);
            PG8_BAR; PG8_WAIT_L(0); PG8_MMA(1, 0, At, B0); PG8_BAR; PG8_SCHED;
            PG8_STAGE(PG8_SB(1, 1), b3 + hsB, voffB);
            PG8_WAIT_V(6); PG8_BAR; PG8_MMA(1, 1, At, B1); PG8_BAR;
            }
        }
        if constexpr (ALIGN_EPI) { if (wr == 0) PG8_BAR; }
        if constexpr (!Epi::AFTER_DRAIN) { E(acc, cur, wr, wc, fr, fq); S.done(cur); }
        if (!has_next) break;
#pragma unroll
        for (int a = 0; a < 2; ++a)
#pragma unroll
            for (int b = 0; b < 2; ++b)
#pragma unroll
                for (int m = 0; m < 4; ++m)
#pragma unroll
                    for (int n = 0; n < 2; ++n) acc[a][b][m][n] = (f32x4){0.f, 0.f, 0.f, 0.f};
        cur = nxt; cA = nA; cB = nB; ++ui;
        if constexpr (ALIGN_EPI) { if (wr == 1) PG8_BAR; }
    }
    PG8_WAIT_V(0);
    if constexpr (!ALIGN_EPI) { if (wr == 0) PG8_BAR; }
    PG8_BAR;
    if constexpr (Epi::AFTER_DRAIN) { E.fused(acc, cur, wr, wc, fr, fq, lds, wid, lane); S.done(cur); }
#undef PG8_SA
#undef PG8_SB
#undef PG8_STAGE
#undef PG8_LDA
#undef PG8_LDB
#undef PG8_MMA
#undef PG8_WAIT_V
#undef PG8_WAIT_L
#undef PG8_BAR
#undef PG8_SCHED
}
}
#define PG8_SP2 true
#define PG8_ALIGN true
namespace attn_body {
typedef unsigned short bf16;
__device__ __forceinline__ unsigned f2bf_(float f){unsigned u=__builtin_bit_cast(unsigned,f);return (u+0x7fffu+((u>>16)&1u))>>16;}
using bf16x8=__attribute__((ext_vector_type(8)))short;
using s16x4=__attribute__((ext_vector_type(4)))short;
using f32x16=__attribute__((ext_vector_type(16)))float;
using u32x4=__attribute__((ext_vector_type(4)))unsigned;
constexpr int D=64,QP=768,KP=128;
constexpr int NW=8,QBLK=32,QB=QBLK*NW,KVBLK=64;
__device__ __forceinline__ int crow(int r,int hi){return (r&3)+8*(r>>2)+4*hi;}
#define SBAR() __builtin_amdgcn_sched_barrier(0)
constexpr int NSLOT=3, SLOTB=8192;
constexpr int LDS_K=0, LDS_V=NSLOT*SLOTB, LDS_WS=2*NSLOT*SLOTB, LDS_OST=LDS_WS+NW*64*4, LDS_BYTES=LDS_OST+NW*4096;
constexpr float C2=0.125f*1.4426950408889634f;
__device__ __forceinline__ void glds16(const void*gsrc,unsigned lds_dst){unsigned keep;
  asm volatile("s_mov_b32 %0, m0\n\ts_mov_b32 m0, %2\n\ts_nop 0\n\tglobal_load_lds_dwordx4 %1, off\n\ts_mov_b32 m0, %0":"=&s"(keep):"v"(gsrc),"s"(lds_dst):"memory");}
__device__ __forceinline__ float max3f(float a,float b,float c){float r;asm("v_max3_f32 %0, %1, %2, %3":"=v"(r):"v"(a),"v"(b),"v"(c));return r;}
__device__ __forceinline__ float max2f(float a,float b){float r;asm("v_max_f32_e32 %0, %1, %2":"=v"(r):"v"(a),"v"(b));return r;}
__device__ __forceinline__ float fadd_s(float a,float b){float r;asm("v_add_f32_e32 %0, %1, %2":"=v"(r):"v"(a),"v"(b));return r;}
__device__ __forceinline__ float fsub_s(float a,float b){float r;asm("v_sub_f32_e32 %0, %1, %2":"=v"(r):"v"(a),"v"(b));return r;}
typedef float f32x2_t __attribute__((ext_vector_type(2))); typedef __bf16 bf16x2_t __attribute__((ext_vector_type(2)));
__device__ __forceinline__ unsigned cvtpk_s(float lo,float hi){f32x2_t v={lo,hi};bf16x2_t b=__builtin_convertvector(v,bf16x2_t);return __builtin_bit_cast(unsigned,b);}
#define WAIT_BAR(N) asm volatile("s_waitcnt vmcnt(" #N ") lgkmcnt(0)\n\ts_barrier":::"memory")

__device__ __forceinline__ void qkt(f32x16&p0,f32x16&p1,const char*Kslot,const bf16x8*qr,const f32x16&negm,int r32,int hi){
  const char*kb=Kslot+hi*1024+r32*16;
  #pragma unroll
  for(int d0=0;d0<4;++d0){
    const bf16x8 b0=*reinterpret_cast<const bf16x8*>(kb+d0*2048);
    const bf16x8 b1=*reinterpret_cast<const bf16x8*>(kb+d0*2048+512);
    if(d0==0){p0=__builtin_amdgcn_mfma_f32_32x32x16_bf16(b0,qr[0],negm,0,0,0);p1=__builtin_amdgcn_mfma_f32_32x32x16_bf16(b1,qr[0],negm,0,0,0);}
    else{p0=__builtin_amdgcn_mfma_f32_32x32x16_bf16(b0,qr[d0],p0,0,0,0);p1=__builtin_amdgcn_mfma_f32_32x32x16_bf16(b1,qr[d0],p1,0,0,0);}}
}
typedef __attribute__((address_space(3))) const char* lds_cptr;
typedef short v4i16_t __attribute__((ext_vector_type(4)));
__device__ __forceinline__ void kload8(bf16x8*kf,lds_cptr kp){
  kf[0]=*(const __attribute__((address_space(3))) bf16x8*)(kp);      kf[1]=*(const __attribute__((address_space(3))) bf16x8*)(kp+512);
  kf[2]=*(const __attribute__((address_space(3))) bf16x8*)(kp+2048); kf[3]=*(const __attribute__((address_space(3))) bf16x8*)(kp+2560);
  kf[4]=*(const __attribute__((address_space(3))) bf16x8*)(kp+4096); kf[5]=*(const __attribute__((address_space(3))) bf16x8*)(kp+4608);
  kf[6]=*(const __attribute__((address_space(3))) bf16x8*)(kp+6144); kf[7]=*(const __attribute__((address_space(3))) bf16x8*)(kp+6656);
}
__device__ __forceinline__ void kload2(bf16x8*kf,lds_cptr kp,int j){ kf[2*j]=*(const __attribute__((address_space(3))) bf16x8*)(kp+j*2048); kf[2*j+1]=*(const __attribute__((address_space(3))) bf16x8*)(kp+j*2048+512); }
__device__ __forceinline__ s16x4 vtr(lds_cptr p){ return __builtin_bit_cast(s16x4,__builtin_amdgcn_ds_read_tr16_b64_v4i16((__attribute__((address_space(3))) v4i16_t*)p)); }
__device__ __forceinline__ float rowmax(const f32x16&p0,const f32x16&p1){
  float a=max3f(p0[0],p0[1],p1[0]),b=max3f(p0[2],p0[3],p1[1]);a=max3f(a,p1[2],p1[3]);
  #pragma unroll
  for(int r=4;r<16;r+=4){a=max3f(a,p0[r],p0[r+1]);b=max3f(b,p0[r+2],p0[r+3]);a=max3f(a,p1[r],p1[r+1]);b=max3f(b,p1[r+2],p1[r+3]);}
  const float m=max2f(a,b);
  auto rr=__builtin_amdgcn_permlane32_swap(__float_as_uint(m),__float_as_uint(m),false,false);
  return max2f(__uint_as_float(rr[0]),__uint_as_float(rr[1]));
}
__device__ __forceinline__ void pv(f32x16*o,int vb,bf16x8 pa0,bf16x8 pa1,bf16x8 pa2,bf16x8 pa3){
  #pragma unroll
  for(int d0=0;d0<2;++d0){s16x4 lo[4],hi[4];
    #pragma unroll
    for(int ks=0;ks<4;++ks){
      asm volatile("ds_read_b64_tr_b16 %0,%1 offset:%c2":"=&v"(lo[ks]):"v"(vb),"i"(d0*4096+ks*1024):"memory");
      asm volatile("ds_read_b64_tr_b16 %0,%1 offset:%c2":"=&v"(hi[ks]):"v"(vb),"i"(d0*4096+ks*1024+512):"memory");}
    asm volatile("s_waitcnt lgkmcnt(0)":::"memory");SBAR();
    #define PK(k) (bf16x8){lo[k][0],lo[k][1],lo[k][2],lo[k][3],hi[k][0],hi[k][1],hi[k][2],hi[k][3]}
    o[d0]=__builtin_amdgcn_mfma_f32_32x32x16_bf16(pa0,PK(0),o[d0],0,0,0);
    o[d0]=__builtin_amdgcn_mfma_f32_32x32x16_bf16(pa1,PK(1),o[d0],0,0,0);
    o[d0]=__builtin_amdgcn_mfma_f32_32x32x16_bf16(pa2,PK(2),o[d0],0,0,0);
    o[d0]=__builtin_amdgcn_mfma_f32_32x32x16_bf16(pa3,PK(3),o[d0],0,0,0);
    #undef PK
  }
}

#ifndef ATTN_STORE16
#define ATTN_STORE16(p,v) (*(u32x4*)(p)=(v))
#endif
template<int THRL,int NT> __device__ __forceinline__ void attn_unit(const bf16*Qu,const bf16*__restrict__ Kh,const bf16*__restrict__ Vh,bf16*Ou,char*shm){
  const int tid=threadIdx.x,lane=tid&63,r32=lane&31,hi=lane>>5; const int wid=__builtin_amdgcn_readfirstlane(tid>>6);
  const bf16*Qw=Qu+(long)(wid*QBLK)*QP;
  const unsigned lds0=(unsigned)(uintptr_t)shm;
  float*wsf=(float*)(shm+LDS_WS)+wid*64;
  const bf16*ksrc=Kh+(long)lane*KP+wid*8;
  const bf16*vsrc=Vh+(long)(16*(wid&3)+(lane>>2))*KP+(wid>>2)*32+(lane&3)*8;
  const unsigned kdst=lds0+LDS_K+wid*1024, vdst=lds0+LDS_V+wid*1024;
  #define DMA_K(t,slot) glds16(ksrc+(long)(t)*KVBLK*KP,(unsigned)__builtin_amdgcn_readfirstlane(kdst+(slot)))
  #define DMA_V(t,slot) glds16(vsrc+(long)(t)*KVBLK*KP,(unsigned)__builtin_amdgcn_readfirstlane(vdst+(slot)))
  const int vb0=(int)(lds0+LDS_V)+((lane>>4)&1)*32+(lane&3)*8+(4*hi+((lane&15)>>2))*64;
  const char*Kbase=shm+LDS_K; bf16x8 kf[8];
  const lds_cptr shm3=(lds_cptr)shm; const lds_cptr kp0=shm3+LDS_K+hi*1024+r32*16; const lds_cptr vp0=shm3+LDS_V+((lane>>4)&1)*32+(lane&3)*8+(4*hi+((lane&15)>>2))*64;
  static_assert(NT>=4&&(NT&1)==0,"NT even, >= 4");
  DMA_K(0,0);DMA_V(0,0);DMA_K(1,SLOTB);
  bf16x8 qr[4];
  #pragma unroll
  for(int d0=0;d0<4;++d0)qr[d0]=*reinterpret_cast<const bf16x8*>(&Qw[(long)r32*QP+d0*16+hi*8]);
  float mhat=0.f,l_reg=0.f;f32x16 o[2];o[0]=f32x16{};o[1]=f32x16{};f32x16 negm=f32x16{};asm volatile("":"+v"(negm));
  bool resc=false;
  #define START(P0,P1) do{ const float rm=rowmax(P0,P1); resc=false; \
    { const float dl=rm; mhat=fadd_s(mhat,dl); \
      _Pragma("unroll") for(int r=0;r<16;++r){P0[r]=fsub_s(P0[r],dl);P1[r]=fsub_s(P1[r],dl);} \
      _Pragma("unroll") for(int r=0;r<16;++r)negm[r]=-mhat; asm volatile("":"+v"(negm)); } \
    _Pragma("unroll") for(int r=0;r<16;++r)P0[r]=__builtin_amdgcn_exp2f(P0[r]); }while(0)
  #define RESC() do{ if(resc){ asm volatile("s_waitcnt lgkmcnt(0)":::"memory"); \
      _Pragma("unroll") for(int d_=0;d_<2;++d_) _Pragma("unroll") for(int r=0;r<16;++r)o[d_][r]*=wsf[crow(r,hi)]; } }while(0)
  f32x16 pA0,pA1,pB0,pB1;
  int sl_prev=0,sl_cur=0,sl_next=SLOTB;
  #define ROT() do{sl_prev=sl_cur;sl_cur=sl_next;sl_next=(sl_next==(NSLOT-1)*SLOTB)?0:sl_next+SLOTB;}while(0)
  DMA_K(2,2*SLOTB);
  WAIT_BAR(3);
  qkt(pA0,pA1,Kbase,qr,negm,r32,hi);asm volatile("s_nop 15\n\ts_nop 7":"+v"(pA0),"+v"(pA1));
  START(pA0,pA1);
  _Pragma("unroll") for(int r=0;r<16;++r)pA1[r]=__builtin_amdgcn_exp2f(pA1[r]);
  WAIT_BAR(0);
  DMA_K(3,0);DMA_V(1,SLOTB);
  ROT();
  kload8(kf,kp0+sl_cur);
  WAIT_BAR(2);
  s16x4 vlo[8],vhi[8]; u32x4 pw0,pw1,pw2,pw3;
  #define PKW(P,B) cvtpk_s(P[B],P[B+1])
  #define PAF(k) __builtin_bit_cast(bf16x8,pw##k)
  #define VFR(i) (bf16x8){vlo[i][0],vlo[i][1],vlo[i][2],vlo[i][3],vhi[i][0],vhi[i][1],vhi[i][2],vhi[i][3]}
  #define PIN(x) asm volatile("":"+v"(x))
  #define MX3(a,b,c) __builtin_fmaxf(__builtin_fmaxf((a),(b)),(c))
  #define GAPA(MF,A0,A1,A2,A3,W0,W1,PW) do{ MF; sacc+=A0; sacc+=A1; sacc+=A2; sacc+=A3; PIN(sacc); W0; W1; PIN(PW); SBAR(); }while(0)
  #define EX(v) __builtin_amdgcn_exp2f(v)
  #define GAPB(MF,X,B) do{ MF; X[B]=EX(X[B]); X[B+1]=EX(X[B+1]); X[B+2]=EX(X[B+2]); X[B+3]=EX(X[B+3]); PIN(X); SBAR(); }while(0)
  #define VRD(i) do{ vlo[i]=vtr(vp_+(((i)>>2)*4096+((i)&3)*1024)); vhi[i]=vtr(vp_+(((i)>>2)*4096+((i)&3)*1024+512)); }while(0)
  #define KRD(G,j) do{ if(G){ kload2(kf,kp0+sl_next,j); SBAR(); } }while(0)
  #define STEP(C0,C1,P0,P1,t,GK,GV,GL) do{ SBAR(); \
    const lds_cptr vp_=vp0+sl_prev; \
    VRD(0); SBAR(); float sacc=(P0[0]+P0[1]); \
    GAPA(C0=__builtin_amdgcn_mfma_f32_32x32x16_bf16(kf[0],qr[0],negm,0,0,0), P0[2],P0[3],P0[4],P0[5],     pw0[0]=PKW(P0,0), pw0[1]=PKW(P0,2), pw0); \
    VRD(4); SBAR(); GAPA(C1=__builtin_amdgcn_mfma_f32_32x32x16_bf16(kf[1],qr[0],negm,0,0,0), P0[6],P0[7],P0[8],P0[9],     pw0[2]=PKW(P0,4), pw0[3]=PKW(P0,6), pw0); \
    VRD(1); SBAR(); GAPA(C0=__builtin_amdgcn_mfma_f32_32x32x16_bf16(kf[2],qr[1],C0,0,0,0),   P0[10],P0[11],P0[12],P0[13], pw1[0]=PKW(P0,8), pw1[1]=PKW(P0,10), pw1); \
    VRD(5); SBAR(); GAPA(C1=__builtin_amdgcn_mfma_f32_32x32x16_bf16(kf[3],qr[1],C1,0,0,0),   P0[14],P0[15],P1[0],P1[1],   pw1[2]=PKW(P0,12),pw1[3]=PKW(P0,14), pw1); \
    VRD(2); SBAR(); GAPA(C0=__builtin_amdgcn_mfma_f32_32x32x16_bf16(kf[4],qr[2],C0,0,0,0),   P1[2],P1[3],P1[4],P1[5],     pw2[0]=PKW(P1,0), pw2[1]=PKW(P1,2), pw2); \
    VRD(6); SBAR(); GAPA(C1=__builtin_amdgcn_mfma_f32_32x32x16_bf16(kf[5],qr[2],C1,0,0,0),   P1[6],P1[7],P1[8],P1[9],     pw2[2]=PKW(P1,4), pw2[3]=PKW(P1,6), pw2); \
    VRD(3); SBAR(); GAPA(C0=__builtin_amdgcn_mfma_f32_32x32x16_bf16(kf[6],qr[3],C0,0,0,0),   P1[10],P1[11],P1[12],P1[13], pw3[0]=PKW(P1,8), pw3[1]=PKW(P1,10), pw3); \
    VRD(7); SBAR(); GAPA(C1=__builtin_amdgcn_mfma_f32_32x32x16_bf16(kf[7],qr[3],C1,0,0,0),   P1[14],P1[15],0.f,0.f,       pw3[2]=PKW(P1,12),pw3[3]=PKW(P1,14), pw3); \
    l_reg+=sacc; \
    if(GK){DMA_K((t)+3,sl_cur);} if(GV){DMA_V((t)+1,sl_next);} \
    { float a=MX3(C0[0],C0[1],C1[0]),b=MX3(C0[2],C0[3],C1[1]); a=MX3(a,C1[2],C1[3]); \
      _Pragma("unroll") for(int r=4;r<16;r+=4){a=MX3(a,C0[r],C0[r+1]);b=MX3(b,C0[r+2],C0[r+3]);a=MX3(a,C1[r],C1[r+1]);b=MX3(b,C1[r+2],C1[r+3]);} \
      float rm=__builtin_fmaxf(a,b); { auto rr=__builtin_amdgcn_permlane32_swap(__float_as_uint(rm),__float_as_uint(rm),false,false); rm=__builtin_fmaxf(__uint_as_float(rr[0]),__uint_as_float(rr[1])); } \
      resc=false; \
      if(__builtin_expect(__any(rm>(float)THRL),0)){ const float dl=__builtin_fmaxf(rm,0.f); mhat+=dl; \
        _Pragma("unroll") for(int r=0;r<16;++r){C0[r]-=dl;C1[r]-=dl;} \
        _Pragma("unroll") for(int r=0;r<16;++r)negm[r]=-mhat; asm volatile("":"+v"(negm)); \
        const float f=__builtin_amdgcn_exp2f(-dl); l_reg*=f; if(hi==0)wsf[r32]=f; resc=true; } } \
    SBAR(); \
    GAPB(o[0]=__builtin_amdgcn_mfma_f32_32x32x16_bf16(PAF(0),VFR(0),o[0],0,0,0), C0,0); \
    GAPB(o[1]=__builtin_amdgcn_mfma_f32_32x32x16_bf16(PAF(0),VFR(4),o[1],0,0,0), C0,4); \
    KRD(GL,0); GAPB(o[0]=__builtin_amdgcn_mfma_f32_32x32x16_bf16(PAF(1),VFR(1),o[0],0,0,0), C0,8); \
    KRD(GL,1); GAPB(o[1]=__builtin_amdgcn_mfma_f32_32x32x16_bf16(PAF(1),VFR(5),o[1],0,0,0), C0,12); \
    KRD(GL,2); GAPB(o[0]=__builtin_amdgcn_mfma_f32_32x32x16_bf16(PAF(2),VFR(2),o[0],0,0,0), C1,0); \
    KRD(GL,3); GAPB(o[1]=__builtin_amdgcn_mfma_f32_32x32x16_bf16(PAF(2),VFR(6),o[1],0,0,0), C1,4); \
    GAPB(o[0]=__builtin_amdgcn_mfma_f32_32x32x16_bf16(PAF(3),VFR(3),o[0],0,0,0), C1,8); \
    GAPB(o[1]=__builtin_amdgcn_mfma_f32_32x32x16_bf16(PAF(3),VFR(7),o[1],0,0,0), C1,12); \
    }while(0)
  int t=1;
  for(;t+5<NT;t+=2){
    STEP(pB0,pB1,pA0,pA1,t,true,true,true);     WAIT_BAR(2); RESC(); ROT();
    STEP(pA0,pA1,pB0,pB1,t+1,true,true,true);   WAIT_BAR(2); RESC(); ROT();
  }
  #define ENDW(tt) do{ if((tt)+3<NT){WAIT_BAR(2);} else if((tt)+2<NT){WAIT_BAR(1);} else {WAIT_BAR(0);} }while(0)
  for(;t+1<NT;t+=2){
    STEP(pB0,pB1,pA0,pA1,t,(t+3<NT),(t+1<NT),(t+1<NT));       ENDW(t);   RESC(); ROT();
    STEP(pA0,pA1,pB0,pB1,t+1,(t+4<NT),(t+2<NT),(t+2<NT));     ENDW(t+1); RESC(); ROT();
  }
  STEP(pB0,pB1,pA0,pA1,NT-1,false,false,false); RESC();
  { float sacc=pB0[0]+pB0[1]; _Pragma("unroll") for(int r=2;r<16;++r)sacc+=pB0[r]; _Pragma("unroll") for(int r=0;r<16;++r)sacc+=pB1[r]; l_reg+=sacc;
    pw0=(u32x4){PKW(pB0,0),PKW(pB0,2),PKW(pB0,4),PKW(pB0,6)};pw1=(u32x4){PKW(pB0,8),PKW(pB0,10),PKW(pB0,12),PKW(pB0,14)};pw2=(u32x4){PKW(pB1,0),PKW(pB1,2),PKW(pB1,4),PKW(pB1,6)};pw3=(u32x4){PKW(pB1,8),PKW(pB1,10),PKW(pB1,12),PKW(pB1,14)};
    SBAR(); pv(o,vb0+sl_cur,PAF(0),PAF(1),PAF(2),PAF(3)); }
  #undef PKW
  #undef PAF
  #undef VFR
  #undef PIN
  #undef MX3
  #undef GAPA
  #undef GAPB
  #undef EX
  #undef VRD
  #undef KRD
  #undef STEP
  #undef ENDW
  {auto rr=__builtin_amdgcn_permlane32_swap(__float_as_uint(l_reg),__float_as_uint(l_reg),false,false);l_reg=__uint_as_float(rr[0])+__uint_as_float(rr[1]);}
  if(hi==0)wsf[32+r32]=l_reg;asm volatile("s_waitcnt lgkmcnt(0)":::"memory");
  float rli[16];
  #pragma unroll
  for(int r=0;r<16;++r)rli[r]=__builtin_amdgcn_rcpf(wsf[32+crow(r,hi)]);
  bf16*Ow=Ou+(long)(wid*QBLK)*QP;
  { bf16*stg=(bf16*)(shm+LDS_OST)+wid*2048;
    #pragma unroll
    for(int r=0;r<16;++r){const int orow=crow(r,hi);
      #pragma unroll
      for(int d0=0;d0<2;++d0)stg[orow*64+d0*32+r32]=(bf16)f2bf_(o[d0][r]*rli[r]);}
    asm volatile("s_waitcnt lgkmcnt(0)":::"memory");
    #pragma unroll
    for(int i=0;i<4;++i){const int row=i*8+(lane>>3),ch=lane&7; const u32x4 v=*(const u32x4*)(stg+row*64+ch*8); ATTN_STORE16(Ow+(long)row*QP+ch*8,v);} }
  asm volatile("s_waitcnt lgkmcnt(0)\n\ts_barrier":::"memory");
  #undef DMA_K
  #undef DMA_V
  #undef START
  #undef RESC
  #undef ROT
}
constexpr int ATTN_LDS_BYTES=LDS_BYTES;
#undef SBAR
#undef WAIT_BAR
}
#define GAS __attribute__((address_space(1)))
#define LAS __attribute__((address_space(3)))
typedef unsigned short bf16;
typedef unsigned v4u __attribute__((ext_vector_type(4)));
typedef float f32x4 __attribute__((ext_vector_type(4)));
typedef short bf16x8 __attribute__((ext_vector_type(8)));
typedef GAS unsigned gu32;
typedef GAS unsigned long long gu64;
#define RLX_AGENT __ATOMIC_RELAXED, __HIP_MEMORY_SCOPE_AGENT
#define LDS_WAIT() asm volatile("s_waitcnt lgkmcnt(0)" ::: "memory")
#define VM_WAIT() asm volatile("s_waitcnt vmcnt(0)" ::: "memory")
__device__ __forceinline__ unsigned long long rt() { return __builtin_amdgcn_s_memrealtime(); }
__device__ __forceinline__ unsigned f2bf(float f) { unsigned u = __builtin_bit_cast(unsigned, f); return (u + 0x7fffu + ((u >> 16) & 1u)) >> 16; }
__device__ __forceinline__ unsigned pk2(float lo, float hi) { return f2bf(lo) | (f2bf(hi) << 16); }

#define XB_TMO      128
#define XB_XCNT(j)  (256  + 64 * (j))
#define XB_XSUB(j)  (1280 + 64 * (j))
#define XB_XGEN(j)  (2304 + 64 * (j))
#define XB_TOP      3328
#define XB_TOPGEN   3392
#define XCD_BAR_WORDS 3456
#define XB_SPIN_CAP (1u << 18)

__device__ __forceinline__ unsigned xb_ld(unsigned* p)              { return __hip_atomic_load(p, __ATOMIC_RELAXED, __HIP_MEMORY_SCOPE_AGENT); }
__device__ __forceinline__ unsigned xb_add(unsigned* p, unsigned v) { return __hip_atomic_fetch_add(p, v, __ATOMIC_RELAXED, __HIP_MEMORY_SCOPE_AGENT); }
__device__ __forceinline__ unsigned xb_xcc_id() { return (unsigned)__builtin_amdgcn_s_getreg((3 << 11) | 20) & 0xFu; }
#define XB_SPIN(cond, bar) do { unsigned _sp = 0; while (cond) { __builtin_amdgcn_s_sleep(1); \
    if ((++_sp & 255u) == 0u) { if (xb_ld(&(bar)[XB_TMO])) break; if (_sp > XB_SPIN_CAP) { atomicAdd(&(bar)[XB_TMO], 1u); break; } } } } while (0)

struct XcdBarrier {
    unsigned* bar; unsigned x;
    volatile LAS unsigned* st;
};

__device__ __forceinline__ XcdBarrier xcd_barrier_post(unsigned* bar, volatile LAS unsigned* st) {
    XcdBarrier b; b.bar = bar; b.x = xb_xcc_id(); b.st = st;
    if (threadIdx.x == 0) (void)xb_add(&bar[XB_XCNT(b.x)], 1u);
    return b;
}
__device__ __forceinline__ void xcd_barrier_complete(unsigned* bar, unsigned x, unsigned& nloc, unsigned& nx) {
    const unsigned G = gridDim.x * gridDim.y * gridDim.z;
    unsigned sum, cnt, mine, sp = 0u;
    for (;;) {
        sum = 0u; cnt = 0u; mine = 0u;
#pragma unroll
        for (unsigned j = 0; j < 16; ++j) { const unsigned c = xb_ld(&bar[XB_XCNT(j)]); sum += c; cnt += (c > 0u) ? 1u : 0u; mine = (j == x) ? c : mine; }
        if (sum == G) break;
        __builtin_amdgcn_s_sleep(1);
        if ((++sp & 255u) == 0u) { if (xb_ld(&bar[XB_TMO])) break; if (sp > XB_SPIN_CAP) { atomicAdd(&bar[XB_TMO], 1u); break; } }
    }
    nloc = mine > 0u ? mine : 1u; nx = cnt > 0u ? cnt : 1u;
}

__device__ __forceinline__ void xcd_barrier(const XcdBarrier& b) {
    asm volatile("s_waitcnt vmcnt(0)" ::: "memory");
    __syncthreads();
    if (threadIdx.x == 0) {
        unsigned* bar = b.bar;
        __builtin_amdgcn_s_waitcnt(0);
        unsigned nloc = b.st[0], nx = b.st[1];
        if (nloc == 0u) { xcd_barrier_complete(bar, b.x, nloc, nx); b.st[0] = nloc; b.st[1] = nx; }
        const unsigned old = xb_add(&bar[XB_XSUB(b.x)], 1u);
        const unsigned gen = old / nloc;
        if (old + 1u == (gen + 1u) * nloc) {
            __builtin_amdgcn_fence(__ATOMIC_RELEASE, "agent");
            asm volatile("s_waitcnt vmcnt(0)" ::: "memory");
            const unsigned og = xb_add(&bar[XB_TOP], 1u);
            const unsigned tg = og / nx;
            if (og + 1u == (tg + 1u) * nx) xb_add(&bar[XB_TOPGEN], 1u);
            else XB_SPIN(xb_ld(&bar[XB_TOPGEN]) == tg, bar);
            __builtin_amdgcn_fence(__ATOMIC_ACQUIRE, "agent");
            xb_add(&bar[XB_XGEN(b.x)], 1u);
            asm volatile("s_waitcnt vmcnt(0)" ::: "memory");
        } else {
            XB_SPIN(xb_ld(&bar[XB_XGEN(b.x)]) == gen, bar);
            __builtin_amdgcn_fence(__ATOMIC_ACQUIRE, "agent");
            asm volatile("s_waitcnt vmcnt(0)" ::: "memory");
        }
    }
    __syncthreads();
}
__device__ __forceinline__ float wave_sum(float v) {
#pragma unroll
    for (int o = 1; o < 64; o <<= 1) v += __shfl_xor(v, o);
    return v;
}
__device__ __forceinline__ void p0_transpose_item(const float* W, int K, int N, bf16* WT, int row_off, LAS float* scr, int item, int lane) {
    const int nblk = N / 32, kb = item / nblk, nb = item % nblk, k0 = 64 * kb, n0 = 32 * nb;
    f32x4 v[8];
#pragma unroll
    for (int i = 0; i < 8; ++i) { const int kk = 8 * i + (lane >> 3); v[i] = *(const f32x4*)(W + (size_t)(k0 + kk) * N + n0 + 4 * (lane & 7)); }
#pragma unroll
    for (int i = 0; i < 8; ++i) { const int kk = 8 * i + (lane >> 3); LAS float* d = scr + kk * 33 + 4 * (lane & 7); d[0] = v[i].x; d[1] = v[i].y; d[2] = v[i].z; d[3] = v[i].w; }
    LDS_WAIT(); asm volatile("" ::: "memory");
    const int c = lane & 7;
#pragma unroll
    for (int j = 0; j < 4; ++j) { const int n = (lane >> 3) + 8 * j; const LAS float* s = scr + (8 * c) * 33 + n;
        v4u o; o.x = pk2(s[0 * 33], s[1 * 33]); o.y = pk2(s[2 * 33], s[3 * 33]); o.z = pk2(s[4 * 33], s[5 * 33]); o.w = pk2(s[6 * 33], s[7 * 33]);
        *(GAS v4u*)(WT + (size_t)(row_off + n0 + n) * K + k0 + 8 * c) = o; }
    LDS_WAIT(); asm volatile("" ::: "memory");
}
namespace hg {
typedef short bf16x8 __attribute__((ext_vector_type(8)));
typedef short v4i16 __attribute__((ext_vector_type(4)));
typedef float f32x16 __attribute__((ext_vector_type(16)));
typedef float f32x4 __attribute__((ext_vector_type(4)));
typedef unsigned u32x2 __attribute__((ext_vector_type(2)));
typedef unsigned u32x4 __attribute__((ext_vector_type(4)));
constexpr int ROWB = 272, TROWB = 80, VROWB = 320, FROWB = 512, QROWB = 256;
constexpr int OFF_F = 0, OFF_RQ = 16384, OFF_V = 24576, OFF_QDT = 34816, OFF_KDT = 45056, OFF_ST = 55296, OFF_SC = 90112, OFF_PL = 100352, OFF_GP = 100864, LDS_END = 102912;
__device__ __forceinline__ int crow(int r, int hi) { return (r & 3) + 8 * (r >> 2) + 4 * hi; }
__device__ __forceinline__ unsigned f2bf(float f) { unsigned u = __builtin_bit_cast(unsigned, f); return (u + 0x7fffu + ((u >> 16) & 1u)) >> 16; }
__device__ __forceinline__ float bflo(unsigned w) { return __uint_as_float(w << 16); }
__device__ __forceinline__ float bfhi(unsigned w) { return __uint_as_float(w & 0xffff0000u); }
__device__ __forceinline__ void lbar() { asm volatile("s_waitcnt lgkmcnt(0)" ::: "memory"); __builtin_amdgcn_s_barrier(); asm volatile("" ::: "memory"); }
__device__ __forceinline__ v4i16 trd(const LAS unsigned char* p) { return __builtin_amdgcn_ds_read_tr16_b64_v4i16((LAS v4i16*)p); }
__device__ __forceinline__ bf16x8 trfrag(const LAS unsigned char* p, int rs) { const v4i16 a = trd(p), b = trd(p + 4 * rs); return (bf16x8){a[0], a[1], a[2], a[3], b[0], b[1], b[2], b[3]}; }
__device__ __forceinline__ void st_image(LAS unsigned char* lds, const f32x16& S, int cb, int vb, int r, int hh) {
    LAS unsigned char* p = lds + OFF_ST + (32 * vb + r) * ROWB + (32 * cb + 4 * hh) * 2;
#pragma unroll
    for (int q4 = 0; q4 < 4; ++q4) { u32x2 w; w.x = f2bf(S[4 * q4]) | (f2bf(S[4 * q4 + 1]) << 16); w.y = f2bf(S[4 * q4 + 2]) | (f2bf(S[4 * q4 + 3]) << 16); *(LAS u32x2*)(p + 16 * q4) = w; }
}
__device__ __forceinline__ void hgrn_unit(LAS unsigned char* lds, const unsigned short* ZH, float* odir, int row0, int L, int h, int dir, const float* s0, float* sfin, const float* lbl) {
    const int tid = threadIdx.x, lane = tid & 63, wid = __builtin_amdgcn_readfirstlane(tid >> 6), r = lane & 31, hh = lane >> 5;
    const int c = (wid & 1) * 64 + lane, g = wid >> 1;
    const int li = tid >> 4, cg = tid & 15;
    const int vb = wid & 3; const bool swave = wid >= 4;
    const int nch = L >> 5;
    float oml[8];
#pragma unroll
    for (int e = 0; e < 8; ++e) { const float l0 = lbl[dir * 1024 + h * 128 + 8 * cg + e], l1 = lbl[dir * 1024 + 512 + h * 128 + 8 * cg + e]; oml[e] = 1.0f - 1.0f / (1.0f + __expf(l1 - l0)); }
    const unsigned short* zl = ZH + (size_t)row0 * 2560 + h * 128 + 8 * cg;
    const int foff = 512 + dir * 512;
    LAS float* PL = (LAS float*)(lds + OFF_PL); LAS float* GP = (LAS float*)(lds + OFF_GP);
    const int trq = (lane & 15) >> 2, trp = lane & 3, trg = (lane >> 4) & 1;
    const int tr80 = (8 * hh + trq) * TROWB + (16 * trg + 4 * trp) * 2;
    const int trv = (8 * hh + trq) * VROWB + (32 * vb + 16 * trg + 4 * trp) * 2;
    u32x4 aq, af, av, bq, bf, bv;
#define HG_ISSUE(m, Q_, F_, V_) do { int m_ = (m); m_ = m_ < nch ? m_ : nch - 1; const int p_ = 32 * m_ + li; const int t_ = dir ? (L - 1 - p_) : p_; const unsigned short* zp = zl + (size_t)t_ * 2560; \
        Q_ = *(const u32x4*)zp; F_ = *(const u32x4*)(zp + foff); V_ = *(const u32x4*)(zp + 1536); } while (0)
#define HG_WRITE_FQ(Q_, F_) do { float x_[8] = {bflo(F_.x), bfhi(F_.x), bflo(F_.y), bfhi(F_.y), bflo(F_.z), bfhi(F_.z), bflo(F_.w), bfhi(F_.w)}; float f_[8]; \
        _Pragma("unroll") for (int e = 0; e < 8; ++e) { const float sg = __builtin_amdgcn_rcpf(1.0f + __builtin_amdgcn_exp2f(-1.4426950408889634f * x_[e])); f_[e] = (1.0f - oml[e]) + oml[e] * sg; } \
        *(LAS f32x4*)(lds + OFF_F + li * FROWB + 32 * cg) = (f32x4){f_[0], f_[1], f_[2], f_[3]}; *(LAS f32x4*)(lds + OFF_F + li * FROWB + 32 * cg + 16) = (f32x4){f_[4], f_[5], f_[6], f_[7]}; \
        *(LAS u32x4*)(lds + OFF_RQ + li * QROWB + 16 * cg) = Q_; } while (0)
#define HG_WRITE_V(V_) do { *(LAS u32x4*)(lds + OFF_V + li * VROWB + 16 * cg) = V_; } while (0)
    f32x16 S0, S1, S2, S3;
    if (swave) {
#pragma unroll
        for (int q = 0; q < 16; ++q) {
            if (s0) { const float* sp = s0 + (size_t)crow(q, hh) * 128 + 32 * vb + r; S0[q] = sp[0]; S1[q] = sp[32 * 128]; S2[q] = sp[64 * 128]; S3[q] = sp[96 * 128]; }
            else { S0[q] = 0.f; S1[q] = 0.f; S2[q] = 0.f; S3[q] = 0.f; }
        }
        st_image(lds, S0, 0, vb, r, hh); st_image(lds, S1, 1, vb, r, hh); st_image(lds, S2, 2, vb, r, hh); st_image(lds, S3, 3, vb, r, hh);
    }
    HG_ISSUE(0, aq, af, av); HG_ISSUE(1, bq, bf, bv);
    HG_WRITE_FQ(aq, af); HG_WRITE_V(av);
    lbar();
#define HG_ITER(n, LQ, LF, LV, NQ, NF, NV, ROLE_S) do { \
        HG_ISSUE((n) + 2, LQ, LF, LV); \
          \
        float pp[8], qf[8], kk[8]; float p = 1.f; \
        _Pragma("unroll") for (int e = 0; e < 8; ++e) { const float f = *(const LAS float*)(lds + OFF_F + (8 * g + e) * FROWB + 4 * c); p *= f; pp[e] = p; kk[e] = 1.0f - f; \
            qf[e] = __uint_as_float((unsigned)*(const LAS unsigned short*)(lds + OFF_RQ + (8 * g + e) * QROWB + 2 * c) << 16) * 0.08838834764831845f; } \
        GP[g * 128 + c] = p; \
        lbar();                                                             \
        float pre = 1.f, pl = 1.f; \
        _Pragma("unroll") for (int g2 = 0; g2 < 4; ++g2) { const float gv = GP[g2 * 128 + c]; pl *= gv; if (g2 < g) pre *= gv; } \
        unsigned qb_[8], kb_[8]; \
        _Pragma("unroll") for (int e = 0; e < 8; ++e) { const float Pi = pre * pp[e]; qb_[e] = f2bf(qf[e] * Pi); kb_[e] = f2bf(kk[e] * __builtin_amdgcn_rcpf(Pi)); } \
        *(LAS u32x4*)(lds + OFF_QDT + c * TROWB + 16 * g) = (u32x4){qb_[0] | (qb_[1] << 16), qb_[2] | (qb_[3] << 16), qb_[4] | (qb_[5] << 16), qb_[6] | (qb_[7] << 16)}; \
        *(LAS u32x4*)(lds + OFF_KDT + c * TROWB + 16 * g) = (u32x4){kb_[0] | (kb_[1] << 16), kb_[2] | (kb_[3] << 16), kb_[4] | (kb_[5] << 16), kb_[6] | (kb_[7] << 16)}; \
        if (g == 0) PL[c] = pl; \
        lbar();                                                             \
        HG_WRITE_FQ(NQ, NF);                                                \
        if (!(ROLE_S)) { \
            f32x16 sc, o; \
            _Pragma("unroll") for (int q = 0; q < 16; ++q) { sc[q] = 0.f; o[q] = 0.f; } \
            bf16x8 qa[8]; \
            _Pragma("unroll") for (int s = 0; s < 8; ++s) { qa[s] = trfrag(lds + OFF_QDT + tr80 + 16 * s * TROWB, TROWB); const bf16x8 kb = trfrag(lds + OFF_KDT + tr80 + 16 * s * TROWB, TROWB); \
                sc = __builtin_amdgcn_mfma_f32_32x32x16_bf16(qa[s], kb, sc, 0, 0, 0); } \
            LAS unsigned short* SCw = (LAS unsigned short*)(lds + OFF_SC + vb * 2560); \
            _Pragma("unroll") for (int q = 0; q < 16; ++q) { const int i = crow(q, hh); SCw[i * (TROWB / 2) + r] = (unsigned short)f2bf(r <= i ? sc[q] : 0.f); } \
            asm volatile("s_waitcnt lgkmcnt(0)" ::: "memory");             \
            const LAS unsigned char* scp = (const LAS unsigned char*)SCw + r * TROWB + 16 * hh; \
            const LAS unsigned char* stp = lds + OFF_ST + (32 * vb + r) * ROWB + 16 * hh; \
            o = __builtin_amdgcn_mfma_f32_32x32x16_bf16(*(const LAS bf16x8*)(scp), trfrag(lds + OFF_V + trv, VROWB), o, 0, 0, 0); \
            o = __builtin_amdgcn_mfma_f32_32x32x16_bf16(*(const LAS bf16x8*)(scp + 32), trfrag(lds + OFF_V + trv + 16 * VROWB, VROWB), o, 0, 0, 0); \
            _Pragma("unroll") for (int s = 0; s < 8; ++s) o = __builtin_amdgcn_mfma_f32_32x32x16_bf16(qa[s], *(const LAS bf16x8*)(stp + 32 * s), o, 0, 0, 0); \
            _Pragma("unroll") for (int q = 0; q < 16; ++q) { const int p_ = 32 * (n) + crow(q, hh); const int t_ = dir ? (L - 1 - p_) : p_; \
                odir[(size_t)dir * 8388608 + (size_t)(row0 + t_) * 512 + h * 128 + 32 * vb + r] = o[q]; } \
        } else { \
            const bf16x8 vf0 = trfrag(lds + OFF_V + trv, VROWB), vf1 = trfrag(lds + OFF_V + trv + 16 * VROWB, VROWB); \
            const LAS unsigned char* kp = lds + OFF_KDT + r * TROWB + 16 * hh; \
            S0 = __builtin_amdgcn_mfma_f32_32x32x16_bf16(*(const LAS bf16x8*)(kp), vf0, S0, 0, 0, 0); S0 = __builtin_amdgcn_mfma_f32_32x32x16_bf16(*(const LAS bf16x8*)(kp + 32), vf1, S0, 0, 0, 0); \
            S1 = __builtin_amdgcn_mfma_f32_32x32x16_bf16(*(const LAS bf16x8*)(kp + 32 * TROWB), vf0, S1, 0, 0, 0); S1 = __builtin_amdgcn_mfma_f32_32x32x16_bf16(*(const LAS bf16x8*)(kp + 32 * TROWB + 32), vf1, S1, 0, 0, 0); \
            S2 = __builtin_amdgcn_mfma_f32_32x32x16_bf16(*(const LAS bf16x8*)(kp + 64 * TROWB), vf0, S2, 0, 0, 0); S2 = __builtin_amdgcn_mfma_f32_32x32x16_bf16(*(const LAS bf16x8*)(kp + 64 * TROWB + 32), vf1, S2, 0, 0, 0); \
            S3 = __builtin_amdgcn_mfma_f32_32x32x16_bf16(*(const LAS bf16x8*)(kp + 96 * TROWB), vf0, S3, 0, 0, 0); S3 = __builtin_amdgcn_mfma_f32_32x32x16_bf16(*(const LAS bf16x8*)(kp + 96 * TROWB + 32), vf1, S3, 0, 0, 0); \
            _Pragma("unroll") for (int q = 0; q < 16; ++q) { const int cc = crow(q, hh); S0[q] *= PL[cc]; S1[q] *= PL[32 + cc]; S2[q] *= PL[64 + cc]; S3[q] *= PL[96 + cc]; } \
        } \
        lbar();                                                             \
        HG_WRITE_V(NV); \
        if (ROLE_S) { st_image(lds, S0, 0, vb, r, hh); st_image(lds, S1, 1, vb, r, hh); st_image(lds, S2, 2, vb, r, hh); st_image(lds, S3, 3, vb, r, hh); } \
    } while (0)
    if (swave) { for (int n = 0; n < nch; n += 2) { HG_ITER(n, aq, af, av, bq, bf, bv, true); HG_ITER(n + 1, bq, bf, bv, aq, af, av, true); } }
    else { for (int n = 0; n < nch; n += 2) { HG_ITER(n, aq, af, av, bq, bf, bv, false); HG_ITER(n + 1, bq, bf, bv, aq, af, av, false); } }
    lbar();
    if (sfin && swave) {
#pragma unroll
        for (int q = 0; q < 16; ++q) { float* sp = sfin + (size_t)crow(q, hh) * 128 + 32 * vb + r; sp[0] = S0[q]; sp[32 * 128] = S1[q]; sp[64 * 128] = S2[q]; sp[96 * 128] = S3[q]; }
    }
#undef HG_ISSUE
#undef HG_WRITE_FQ
#undef HG_WRITE_V
#undef HG_ITER
}
}
constexpr int NWAVES = 8;
constexpr int NPH = 12;
constexpr int DMODEL = 1024, MROWS = 16384, MCTX = 8192, NZ = 5376, FFD = 4096;
constexpr int ZH_LD = 2560, ZA_LD = 768, ZG_LD = 2048;
constexpr float EPSN = 1e-6f;
constexpr float ATT_C2 = 0.125f * 1.4426950408889634f;
constexpr size_t OUT_Y = 0, OUT_CK = 16777216, OUT_CV = 17825792, OUT_ST = 18874368, OUT_TOTAL = 23068672;
constexpr size_t MiB = 1u << 20;
constexpr size_t WS_CTL = 0, CTL_ZERO_BYTES = 512 * 1024;
constexpr size_t WS_MOD = 1 * MiB, WS_ROPE = 1 * MiB + 512 * 1024;
constexpr size_t WS_WIN = 2 * MiB, WS_WHO = 13 * MiB, WS_WAO = 14 * MiB, WS_WOUT = 15 * MiB, WS_WF1 = 17 * MiB, WS_WF2 = 25 * MiB;
constexpr size_t WS_KC = 33 * MiB, WS_VC = 35 * MiB, WS_KL = 37 * MiB, WS_VL = 40 * MiB;
constexpr size_t WS_XN = 44 * MiB;
constexpr size_t WS_ZH = 76 * MiB, WS_ZA = 156 * MiB, WS_ZG = 180 * MiB, WS_END = 244 * MiB;
constexpr size_t WS_HB = 76 * MiB;
static_assert(WS_WIN + (size_t)NZ * DMODEL * 2 <= WS_WHO && WS_ZH + (size_t)MROWS * ZH_LD * 2 == WS_ZA && WS_ZA + (size_t)MROWS * ZA_LD * 2 == WS_ZG && WS_ZG + (size_t)MROWS * ZG_LD * 2 == WS_END, "d_ws map");
static_assert(WS_HB + (size_t)MROWS * FFD * 2 <= WS_END && WS_XN + (size_t)MROWS * DMODEL * 2 == WS_ZH && WS_VL + 3 * MiB <= WS_XN, "d_ws map 2");
constexpr int CW_QUEUE = 64;
constexpr int CW_BAR = 4096;
constexpr int RING_OFF = 0, RING_BYTES = 131072;
constexpr int LDSCTL_OFF = RING_BYTES, MISC_OFF = LDSCTL_OFF + 320;
constexpr int LDS_BYTES = 147456;
static_assert(MISC_OFF + 128 <= LDS_BYTES && hg::LDS_END <= RING_BYTES && attn_body::LDS_BYTES <= RING_BYTES, "LDS map");

struct Frame {
    LAS unsigned char* lds;
    volatile LAS unsigned* MISC;
    gu32* ctl;
    int tid, lane, wave;
    int vcu, G;
    const float *x_prompt, *x_sample, *cache_k, *cache_v, *state, *c, *c_ctx, *w_ada, *b_ada, *norm_mix_w, *w_in, *q_norm_w, *k_norm_w, *lb_logits, *hgrn_norm_w, *w_ho, *w_ao, *w_out, *norm_ffn_w, *w_ff1, *w_ff2, *final_w;
    float* out;
    float* MOD; float* ROPE;
    bf16 *WIN, *WHO, *WAO, *WOUT, *WF1, *WF2, *KC, *VC, *KL, *VL, *XN, *ZH, *ZA, *ZG, *HB;
};
__device__ __forceinline__ float bf2f(unsigned short h) { return __uint_as_float((unsigned)h << 16); }
__device__ __forceinline__ float bflo(unsigned w) { return __uint_as_float(w << 16); }
__device__ __forceinline__ float bfhi(unsigned w) { return __uint_as_float(w & 0xffff0000u); }
__device__ __forceinline__ float sigmf(float x) { return __builtin_amdgcn_rcpf(1.0f + __builtin_amdgcn_exp2f(-1.4426950408889634f * x)); }

__device__ __forceinline__ void p0_prologue(Frame& F) {
    {
        LAS float* sil = (LAS float*)(F.lds + RING_OFF);
        LAS float* red = sil + 9 * 1024;
        for (int i = F.tid; i < 9 * 1024; i += NWAVES * 64) { const int r = i >> 10, k = i & 1023; const float x = (r == 0) ? F.c_ctx[k] : F.c[(r - 1) * 1024 + k]; sil[i] = x * sigmf(x); }
        __syncthreads();
        for (int slab = blockIdx.x; slab < 256; slab += F.G) {
            const int n0 = 24 * slab, rl = F.tid / 6, cq = F.tid % 6;
            if (F.tid < 504) {
                f32x4 w[13];
#pragma unroll
                for (int i = 0; i < 13; ++i) { const int k = rl + 84 * i; w[i] = (f32x4){0.f, 0.f, 0.f, 0.f}; if (k < 1024) w[i] = *(const f32x4*)(F.w_ada + (size_t)k * 6144 + n0 + 4 * cq); }
                f32x4 acc[9];
#pragma unroll
                for (int r = 0; r < 9; ++r) acc[r] = (f32x4){0.f, 0.f, 0.f, 0.f};
#pragma unroll
                for (int i = 0; i < 13; ++i) { const int k = rl + 84 * i, kc = k < 1024 ? k : 1023;
#pragma unroll
                    for (int r = 0; r < 9; ++r) acc[r] += w[i] * sil[r * 1024 + kc]; }
#pragma unroll
                for (int r = 0; r < 9; ++r) *(LAS f32x4*)(red + (rl * 9 + r) * 24 + 4 * cq) = acc[r];
            }
            __syncthreads();
            if (F.tid < 216) { const int r = F.tid / 24, jj = F.tid % 24; float s = F.b_ada[n0 + jj];
                for (int k2 = 0; k2 < 84; ++k2) s += red[(k2 * 9 + r) * 24 + jj];
                F.MOD[(size_t)r * 6144 + n0 + jj] = s; }
            __syncthreads();
        }
    }
    if (blockIdx.x == 0) {
        for (int i = F.tid; i < 1024; i += NWAVES * 64) { const int pos = i >> 4, fi = i & 15;
            const float freq = __builtin_amdgcn_exp2f(-(float)fi * (13.287712379549449f / 16.0f));
            const float ang = (float)pos * freq; const float nrev = rintf(ang * 0.15915494309189535f);
            float rr = fmaf(-nrev, 6.28125f, ang); rr = fmaf(-nrev, 1.9353071795864769e-3f, rr);
            F.ROPE[2 * i] = __cosf(rr); F.ROPE[2 * i + 1] = __sinf(rr); }
    }
    LAS float* scr = (LAS float*)(F.lds + RING_OFF + F.wave * 16384);
    const int gw = F.vcu * NWAVES + F.wave, NGW = F.G * NWAVES;
    constexpr int I_IN = (1024 / 64) * (NZ / 32), I_HO = (512 / 64) * (1024 / 32), I_AO = I_HO, I_OUT = (1024 / 64) * (1024 / 32), I_F1 = (1024 / 64) * (FFD / 32), I_F2 = (FFD / 64) * (1024 / 32);
    constexpr int NITEMS = I_IN + I_HO + I_AO + I_OUT + I_F1 + I_F2;
    for (int it = gw; it < NITEMS; it += NGW) {
        int r = it;
        if (r < I_IN) { p0_transpose_item(F.w_in, 1024, NZ, F.WIN, 0, scr, r, F.lane); continue; } r -= I_IN;
        if (r < I_HO) { p0_transpose_item(F.w_ho, 512, 1024, F.WHO, 0, scr, r, F.lane); continue; } r -= I_HO;
        if (r < I_AO) { p0_transpose_item(F.w_ao, 512, 1024, F.WAO, 0, scr, r, F.lane); continue; } r -= I_AO;
        if (r < I_OUT) { p0_transpose_item(F.w_out, 1024, 1024, F.WOUT, 0, scr, r, F.lane); continue; } r -= I_OUT;
        if (r < I_F1) { p0_transpose_item(F.w_ff1, 1024, FFD, F.WF1, 0, scr, r, F.lane); continue; } r -= I_F1;
        p0_transpose_item(F.w_ff2, FFD, 1024, F.WF2, 0, scr, r, F.lane);
    }
    for (int i = blockIdx.x * (NWAVES * 64) + F.tid; i < 2 * 65536; i += F.G * NWAVES * 64) {
        const int which = i >> 16, ii = i & 65535, b = ii >> 13, t = (ii >> 4) & 511, chn = ii & 15;
        const float* src = (which ? F.cache_v : F.cache_k) + (size_t)ii * 8;
        const f32x4 a = *(const f32x4*)src, bq = *(const f32x4*)(src + 4);
        v4u o; o.x = pk2(a.x, a.y); o.y = pk2(a.z, a.w); o.z = pk2(bq.x, bq.y); o.w = pk2(bq.z, bq.w);
        *(v4u*)((which ? F.VL : F.KL) + ((size_t)b * 1536 + t) * 128 + chn * 8) = o;
    }
}
__device__ __forceinline__ void norm_mod_rows(Frame& F, const float* src_lo, const float* src_hi, bf16* dst, const float* nw, int sh_off, int sc_off) {
    const int gw = F.vcu * NWAVES + F.wave, NGW = F.G * NWAVES;
    for (int m0 = gw * 8; m0 < MROWS; m0 += NGW * 8) {
        const int req = m0 < MCTX ? 0 : 1 + ((m0 - MCTX) >> 10);
        const float* modr = F.MOD + (size_t)req * 6144;
        f32x4 gvec[4], svec[4];
#pragma unroll
        for (int j = 0; j < 4; ++j) { const int col = 4 * F.lane + 256 * j; const f32x4 w = *(const f32x4*)(nw + col), sc = *(const f32x4*)(modr + sc_off + col); gvec[j] = w * (sc + 1.0f); svec[j] = *(const f32x4*)(modr + sh_off + col); }
        for (int rr = 0; rr < 8; ++rr) { const int m = m0 + rr;
            const float* xrow = m < MCTX ? src_lo + (size_t)m * 1024 : src_hi + (size_t)(m - MCTX) * 1024;
            const f32x4* xr = (const f32x4*)xrow + F.lane;
            f32x4 v[4]; float s = 0.f;
#pragma unroll
            for (int j = 0; j < 4; ++j) { v[j] = xr[64 * j]; s += (v[j].x * v[j].x + v[j].y * v[j].y) + (v[j].z * v[j].z + v[j].w * v[j].w); }
            const float rstd = 1.0f / sqrtf(wave_sum(s) * (1.f / 1024.f) + EPSN);
            unsigned long long* o8 = (unsigned long long*)(dst + (size_t)m * 1024) + F.lane;
#pragma unroll
            for (int j = 0; j < 4; ++j) { const f32x4 y = v[j] * rstd * gvec[j] + svec[j]; o8[64 * j] = (unsigned long long)pk2(y.x, y.y) | ((unsigned long long)pk2(y.z, y.w) << 32); }
        }
    }
}
__device__ __forceinline__ void p3_qk(Frame& F, bf16* qdst) {
    const int gw = F.vcu * NWAVES + F.wave, NGW = F.G * NWAVES, l = F.lane, sub = l & 7;
    float qw[8], kw[8];
#pragma unroll
    for (int e = 0; e < 8; ++e) { qw[e] = F.q_norm_w[8 * sub + e]; kw[e] = F.k_norm_w[8 * sub + e]; }
    for (int m0 = gw * 8; m0 < MROWS; m0 += NGW * 8) {
        for (int rr = 0; rr < 8; ++rr) { const int row = m0 + rr;
            const bool latent = row >= MCTX; const int t = latent ? ((row - MCTX) & 1023) : (row & 255); const int b = latent ? ((row - MCTX) >> 10) : (row >> 8);
            bf16* zr = F.ZA + (size_t)row * ZA_LD;
            const v4u qraw = *(const v4u*)(zr + 8 * l);
            v4u kvraw = (v4u){0u, 0u, 0u, 0u}; if (l < 32) kvraw = *(const v4u*)(zr + 512 + 8 * l);
            float cs[8], sn[8];
            if (latent) { const int pos = (sub < 4) ? (t >> 6) : (t & 63); const float* tp = F.ROPE + 2 * (pos * 16 + 8 * (sub & 1));
#pragma unroll
                for (int e = 0; e < 8; e += 2) { const f32x4 w = *(const f32x4*)(tp + 2 * e); cs[e] = w.x; sn[e] = w.y; cs[e + 1] = w.z; sn[e + 1] = w.w; } }
            else {
#pragma unroll
                for (int e = 0; e < 8; ++e) { cs[e] = 1.f; sn[e] = 0.f; } }
            float q[8] = {bflo(qraw.x), bfhi(qraw.x), bflo(qraw.y), bfhi(qraw.y), bflo(qraw.z), bfhi(qraw.z), bflo(qraw.w), bfhi(qraw.w)};
            float ss = 0.f;
#pragma unroll
            for (int e = 0; e < 8; ++e) ss += q[e] * q[e];
            ss += __shfl_xor(ss, 1); ss += __shfl_xor(ss, 2); ss += __shfl_xor(ss, 4);
            float rstd = 1.0f / sqrtf(ss * (1.f / 64.f) + EPSN);
#pragma unroll
            for (int e = 0; e < 8; ++e) { q[e] = q[e] * rstd * qw[e]; }
            if (latent) {
#pragma unroll
                for (int e = 0; e < 8; ++e) { const float pr = __shfl_xor(q[e], 2); q[e] = (sub & 2) ? (q[e] * cs[e] + pr * sn[e]) : (q[e] * cs[e] - pr * sn[e]); } }
            { v4u o; o.x = pk2(q[0] * ATT_C2, q[1] * ATT_C2); o.y = pk2(q[2] * ATT_C2, q[3] * ATT_C2); o.z = pk2(q[4] * ATT_C2, q[5] * ATT_C2); o.w = pk2(q[6] * ATT_C2, q[7] * ATT_C2); *(v4u*)(qdst + (size_t)row * ZA_LD + 8 * l) = o; }
            float k[8] = {bflo(kvraw.x), bfhi(kvraw.x), bflo(kvraw.y), bfhi(kvraw.y), bflo(kvraw.z), bfhi(kvraw.z), bflo(kvraw.w), bfhi(kvraw.w)};
            float ks = 0.f;
#pragma unroll
            for (int e = 0; e < 8; ++e) ks += k[e] * k[e];
            ks += __shfl_xor(ks, 1); ks += __shfl_xor(ks, 2); ks += __shfl_xor(ks, 4);
            rstd = 1.0f / sqrtf(ks * (1.f / 64.f) + EPSN);
            float kn[8];
#pragma unroll
            for (int e = 0; e < 8; ++e) kn[e] = k[e] * rstd * kw[e];
            if (!latent) {
                if (l < 16) { float* op = F.out + OUT_CK + (size_t)row * 128 + 8 * l; *(f32x4*)op = (f32x4){kn[0], kn[1], kn[2], kn[3]}; *(f32x4*)(op + 4) = (f32x4){kn[4], kn[5], kn[6], kn[7]}; }
                else if (l < 32) { float* op = F.out + OUT_CV + (size_t)row * 128 + 8 * (l - 16); *(f32x4*)op = (f32x4){k[0], k[1], k[2], k[3]}; *(f32x4*)(op + 4) = (f32x4){k[4], k[5], k[6], k[7]}; }
            } else {
#pragma unroll
                for (int e = 0; e < 8; ++e) { const float pr = __shfl_xor(kn[e], 2); kn[e] = (sub & 2) ? (kn[e] * cs[e] + pr * sn[e]) : (kn[e] * cs[e] - pr * sn[e]); } }
            bf16* kdst = latent ? F.KL + ((size_t)b * 1536 + 512 + t) * 128 : F.KC + (size_t)row * 128;
            bf16* vdst = latent ? F.VL + ((size_t)b * 1536 + 512 + t) * 128 : F.VC + (size_t)row * 128;
            if (l < 16) { v4u o; o.x = pk2(kn[0], kn[1]); o.y = pk2(kn[2], kn[3]); o.z = pk2(kn[4], kn[5]); o.w = pk2(kn[6], kn[7]); *(v4u*)(kdst + 8 * l) = o; }
            else if (l < 32) { *(v4u*)(vdst + 8 * (l - 16)) = kvraw; }
        }
    }
}
__device__ __forceinline__ void p5_combine(Frame& F) {
    const int gw = F.vcu * NWAVES + F.wave, NGW = F.G * NWAVES, l = F.lane;
    float wn[8];
#pragma unroll
    for (int e = 0; e < 8; ++e) wn[e] = F.hgrn_norm_w[8 * (l & 15) + e];
    const float* od0 = F.out + OUT_Y; const float* od1 = od0 + (size_t)MROWS * 512;
    for (int m = gw; m < MROWS; m += NGW) {
        const float* a = od0 + (size_t)m * 512 + 8 * l; const float* bq = od1 + (size_t)m * 512 + 8 * l;
        const f32x4 a0 = *(const f32x4*)a, a1 = *(const f32x4*)(a + 4), b0 = *(const f32x4*)bq, b1 = *(const f32x4*)(bq + 4);
        bf16* zr = F.ZH + (size_t)m * ZH_LD;
        const v4u graw = *(const v4u*)(zr + 2048 + 8 * l);
        float o[8] = {a0.x + b0.x, a0.y + b0.y, a0.z + b0.z, a0.w + b0.w, a1.x + b1.x, a1.y + b1.y, a1.z + b1.z, a1.w + b1.w};
        float ss = 0.f;
#pragma unroll
        for (int e = 0; e < 8; ++e) ss += o[e] * o[e];
        ss += __shfl_xor(ss, 1); ss += __shfl_xor(ss, 2); ss += __shfl_xor(ss, 4); ss += __shfl_xor(ss, 8);
        const float rstd = 1.0f / sqrtf(ss * (1.f / 128.f) + EPSN);
        const float hgv[8] = {bflo(graw.x), bfhi(graw.x), bflo(graw.y), bfhi(graw.y), bflo(graw.z), bfhi(graw.z), bflo(graw.w), bfhi(graw.w)};
        float y[8];
#pragma unroll
        for (int e = 0; e < 8; ++e) y[e] = o[e] * rstd * wn[e] * hgv[e] * sigmf(hgv[e]);
        v4u w; w.x = pk2(y[0], y[1]); w.y = pk2(y[2], y[3]); w.z = pk2(y[4], y[5]); w.w = pk2(y[6], y[7]);
        *(v4u*)(zr + 8 * l) = w;
    }
}
__device__ __forceinline__ void p11_final(Frame& F, float* dst) {
    const int gw = F.vcu * NWAVES + F.wave, NGW = F.G * NWAVES;
    f32x4 wv[4];
#pragma unroll
    for (int j = 0; j < 4; ++j) wv[j] = *(const f32x4*)(F.final_w + 4 * F.lane + 256 * j);
    for (int m = gw; m < MROWS; m += NGW) {
        f32x4* xr = (f32x4*)(F.out + OUT_Y + (size_t)m * 1024) + F.lane;
        f32x4 v[4]; float s = 0.f;
#pragma unroll
        for (int j = 0; j < 4; ++j) { v[j] = xr[64 * j]; s += (v[j].x * v[j].x + v[j].y * v[j].y) + (v[j].z * v[j].z + v[j].w * v[j].w); }
        const float rstd = 1.0f / sqrtf(wave_sum(s) * (1.f / 1024.f) + EPSN);
        f32x4* yr = (f32x4*)(dst + (size_t)m * 1024) + F.lane;
#pragma unroll
        for (int j = 0; j < 4; ++j) yr[64 * j] = v[j] * rstd * wv[j];
    }
}
constexpr int MIX_HL = 64, MIX_HC = 256, MIX_H = MIX_HL + MIX_HC, MIX_AL = 256, MIX_AC = 256, MIX_A = MIX_AL + MIX_AC;
__device__ __forceinline__ void p4_hgrn_item(Frame& F, int it) {
    float* odir = F.out + OUT_Y;
    if (it < MIX_HL) { const int b = it >> 3, h = (it >> 1) & 3, dir = it & 1;
        hg::hgrn_unit(F.lds + RING_OFF, F.ZH, odir, MCTX + b * 1024, 1024, h, dir, F.state + (size_t)((b * 2 + dir) * 4 + h) * 16384, nullptr, F.lb_logits);
    } else { const int u = it - MIX_HL, b = u >> 3, h = (u >> 1) & 3, dir = u & 1;
        hg::hgrn_unit(F.lds + RING_OFF, F.ZH, odir, b * 256, 256, h, dir, nullptr, F.out + OUT_ST + (size_t)((b * 2 + dir) * 4 + h) * 16384, F.lb_logits);
    }
}
__device__ __forceinline__ void p4_attn_item(Frame& F, unsigned char* lds_generic, int it, bool scratch_out) {
    if (it < MIX_AL) { const int u = it, b = u >> 5, head = (u >> 2) & 7, qb = u & 3;
        bf16* q = F.ZA + (size_t)(MCTX + b * 1024 + qb * 256) * ZA_LD + head * 64;
        attn_body::attn_unit<8, 24>(q, F.KL + (size_t)b * 1536 * 128 + (head >> 2) * 64, F.VL + (size_t)b * 1536 * 128 + (head >> 2) * 64, scratch_out ? F.XN + (q - F.ZA) : q, (char*)lds_generic + RING_OFF);
    } else { const int u = it - MIX_AL, b = u >> 3, head = u & 7;
        bf16* q = F.ZA + (size_t)(b * 256) * ZA_LD + head * 64;
        attn_body::attn_unit<8, 4>(q, F.KC + (size_t)b * 256 * 128 + (head >> 2) * 64, F.VC + (size_t)b * 256 * 128 + (head >> 2) * 64, scratch_out ? F.XN + (q - F.ZA) : q, (char*)lds_generic + RING_OFF);
    }
}
#ifndef MK_REP0
#define MK_REP0 1
#endif
#ifndef MK_REP1
#define MK_REP1 1
#endif
#ifndef MK_REP2
#define MK_REP2 1
#endif
#ifndef MK_REP4H
#define MK_REP4H 1
#endif
#ifndef MK_REP4A
#define MK_REP4A 1
#endif
#ifndef MK_REP5
#define MK_REP5 1
#endif
#ifndef MK_REP7
#define MK_REP7 1
#endif
#ifndef MK_REP8
#define MK_REP8 1
#endif
#ifndef MK_REP9
#define MK_REP9 1
#endif
#ifndef MK_REP10
#define MK_REP10 1
#endif
#ifndef MK_REP5C
#define MK_REP5C 1
#endif
#ifndef MK_REP5G
#define MK_REP5G 1
#endif
#ifndef MK_REP3
#define MK_REP3 1
#endif
#ifndef MK_REP11
#define MK_REP11 1
#endif
#ifndef MK_REPALL
#define MK_REPALL 1
#endif
#ifndef MK_REP4
#define MK_REP4 1
#endif
#ifndef MK_SEQ
#define MK_SEQ {{0, NPH, 0}}
#endif
#ifndef MK_REPBAR
#define MK_REPBAR 0
#endif
struct Args { const float* in[22]; float* out; unsigned char* ws; int ph_lo, ph_hi, flags, pad; };
__global__ void __launch_bounds__(NWAVES * 64, 2) mk_fwd(Args args) {
    extern __shared__ __attribute__((aligned(16))) unsigned char lds[];
    Frame F;
    F.lds = (LAS unsigned char*)lds;
    F.MISC = (volatile LAS unsigned*)(F.lds + MISC_OFF);
    F.tid = threadIdx.x; F.lane = F.tid & 63; F.wave = __builtin_amdgcn_readfirstlane(F.tid >> 6);
    F.G = gridDim.x; { const int bx = blockIdx.x; F.vcu = (F.G % 8 == 0) ? (bx % 8) * (F.G / 8) + bx / 8 : bx; }
    unsigned char* ws = args.ws;
    F.ctl = (gu32*)(ws + WS_CTL);
    F.x_prompt = args.in[0]; F.x_sample = args.in[1]; F.cache_k = args.in[2]; F.cache_v = args.in[3]; F.state = args.in[4]; F.c = args.in[5]; F.c_ctx = args.in[6];
    F.w_ada = args.in[7]; F.b_ada = args.in[8]; F.norm_mix_w = args.in[9]; F.w_in = args.in[10]; F.q_norm_w = args.in[11]; F.k_norm_w = args.in[12]; F.lb_logits = args.in[13];
    F.hgrn_norm_w = args.in[14]; F.w_ho = args.in[15]; F.w_ao = args.in[16]; F.w_out = args.in[17]; F.norm_ffn_w = args.in[18]; F.w_ff1 = args.in[19]; F.w_ff2 = args.in[20]; F.final_w = args.in[21];
    F.out = args.out;
    F.MOD = (float*)(ws + WS_MOD); F.ROPE = (float*)(ws + WS_ROPE);
    F.WIN = (bf16*)(ws + WS_WIN); F.WHO = (bf16*)(ws + WS_WHO); F.WAO = (bf16*)(ws + WS_WAO); F.WOUT = (bf16*)(ws + WS_WOUT); F.WF1 = (bf16*)(ws + WS_WF1); F.WF2 = (bf16*)(ws + WS_WF2);
    F.KC = (bf16*)(ws + WS_KC); F.VC = (bf16*)(ws + WS_VC); F.KL = (bf16*)(ws + WS_KL); F.VL = (bf16*)(ws + WS_VL);
    F.XN = (bf16*)(ws + WS_XN); F.ZH = (bf16*)(ws + WS_ZH); F.ZA = (bf16*)(ws + WS_ZA); F.ZG = (bf16*)(ws + WS_ZG); F.HB = (bf16*)(ws + WS_HB);
    for (int u = F.tid; u < (LDS_BYTES - LDSCTL_OFF) / 4; u += NWAVES * 64) ((LAS unsigned*)(F.lds + LDSCTL_OFF))[u] = 0u;
    __syncthreads();
    const int lo = args.ph_lo, hi = args.ph_hi; const bool dummy = (args.flags & 1) != 0; const bool use_bar = (hi - lo) > 1;
    XcdBarrier bar; bar.bar = (unsigned*)(F.ctl + CW_BAR); bar.x = 0; bar.st = nullptr;
    if (use_bar) bar = xcd_barrier_post((unsigned*)(F.ctl + CW_BAR), F.MISC + 8);
#define GRID_BAR() do { if (use_bar) xcd_barrier(bar); } while (0)
#define IN(k) (lo <= (k) && (k) < hi)
#define BOTH(k) (IN(k) && IN((k) + 1))

    if (IN(0)) { for (int rep = 0; rep < MK_REP0; ++rep) { p0_prologue(F); if (BOTH(0)) GRID_BAR(); } for (int rep = 0; rep < MK_REPBAR; ++rep) GRID_BAR(); }
    if (IN(1)) { for (int rep = 0; rep < MK_REP1; ++rep) { norm_mod_rows(F, F.x_prompt, F.x_sample, F.XN, F.norm_mix_w, 0, 1024); if (BOTH(1)) GRID_BAR(); } }
    if (IN(2)) for (int rep = 0; rep < MK_REP2; ++rep) {
        pg8::Gemm g{F.XN, F.WIN, MROWS, NZ, 1024, 1024}; pg8::StaticOrder S; S.init(MROWS, NZ, F.G, (int)blockIdx.x);
        pg8::EpiZ E{F.ZH, F.ZA, F.ZG};
        pg8::gemm_phase<pg8::EpiZ, pg8::StaticOrder, PG8_ALIGN, PG8_SP2>(F.lds + RING_OFF, g, S, E);
        if (BOTH(2)) GRID_BAR();
    }
    if (IN(3)) { for (int rep = MK_REP3 - 1; rep >= 0; --rep) { p3_qk(F, (rep > 0 || dummy) ? F.XN : F.ZA); if (BOTH(3)) GRID_BAR(); } }
    if (IN(4)) {
        for (int rep = 0; rep < MK_REP4H; ++rep)
        for (int it = (int)blockIdx.x; it < MIX_H; ) {
            p4_hgrn_item(F, it);
            if (F.tid == 0) F.MISC[4] = (unsigned)F.G + __hip_atomic_fetch_add((unsigned*)(F.ctl + CW_QUEUE + 128 * rep), 1u, __ATOMIC_RELAXED, __HIP_MEMORY_SCOPE_AGENT);
            __syncthreads();
            it = (int)F.MISC[4];
            __syncthreads();
        }
        for (int rep = MK_REP4A - 1; rep >= 0; --rep)
        for (;;) {
            if (F.tid == 0) F.MISC[5] = __hip_atomic_fetch_add((unsigned*)(F.ctl + CW_QUEUE + 64 + 128 * rep), 1u, __ATOMIC_RELAXED, __HIP_MEMORY_SCOPE_AGENT);
            __syncthreads();
            const int it = (int)F.MISC[5];
            __syncthreads();
            if (it >= MIX_A) break;
            p4_attn_item(F, lds, it, rep > 0 || dummy);
        }
        if (BOTH(4)) GRID_BAR();
    }
    if (IN(5)) for (int rep = 0; rep < MK_REP5; ++rep) {
        for (int rc = 0; rc < MK_REP5C; ++rc) p5_combine(F);
        pg8::Gemm g{F.ZA, F.WAO, MROWS, 1024, 512, ZA_LD}; pg8::StaticOrder S; S.init(MROWS, 1024, F.G, (int)blockIdx.x);
        pg8::EpiGate<false> E{F.ZG + 1024, ZG_LD, F.XN, 1024};
        for (int rg = 0; rg < MK_REP5G; ++rg) pg8::gemm_phase<pg8::EpiGate<false>, pg8::StaticOrder, PG8_ALIGN, PG8_SP2>(F.lds + RING_OFF, g, S, E);
        if (BOTH(5)) GRID_BAR();
    }
    if (IN(6)) {
        pg8::Gemm g{F.ZH, F.WHO, MROWS, 1024, 512, ZH_LD}; pg8::StaticOrder S; S.init(MROWS, 1024, F.G, (int)blockIdx.x);
        pg8::EpiGate<true> E{F.ZG, ZG_LD, dummy ? (bf16*)(F.out + OUT_Y) : F.XN, 1024};
        pg8::gemm_phase<pg8::EpiGate<true>, pg8::StaticOrder, PG8_ALIGN, PG8_SP2>(F.lds + RING_OFF, g, S, E);
        if (BOTH(6)) GRID_BAR();
    }
    if (IN(7)) for (int rep = 0; rep < MK_REP7; ++rep) {
        pg8::Gemm g{F.XN, F.WOUT, MROWS, 1024, 1024, 1024}; pg8::StaticOrder S; S.init(MROWS, 1024, F.G, (int)blockIdx.x);
        pg8::EpiResid E{F.x_prompt, F.x_sample, F.out + OUT_Y, F.MOD + 2048};
        pg8::gemm_phase<pg8::EpiResid, pg8::StaticOrder, PG8_ALIGN, PG8_SP2>(F.lds + RING_OFF, g, S, E);
        if (BOTH(7)) GRID_BAR();
    }
    if (IN(8)) { for (int rep = 0; rep < MK_REP8; ++rep) { norm_mod_rows(F, F.out + OUT_Y, F.out + OUT_Y + (size_t)MCTX * 1024, F.XN, F.norm_ffn_w, 3072, 4096); if (BOTH(8)) GRID_BAR(); } }
    if (IN(9)) for (int rep = 0; rep < MK_REP9; ++rep) {
        pg8::Gemm g{F.XN, F.WF1, MROWS, FFD, 1024, 1024}; pg8::StaticOrder S; S.init(MROWS, FFD, F.G, (int)blockIdx.x);
        pg8::EpiRelu2 E{F.HB, FFD};
        pg8::gemm_phase<pg8::EpiRelu2, pg8::StaticOrder, PG8_ALIGN, PG8_SP2>(F.lds + RING_OFF, g, S, E);
        if (BOTH(9)) GRID_BAR();
    }
    if (IN(10)) for (int rep = MK_REP10 - 1; rep >= 0; --rep) {
        pg8::Gemm g{F.HB, F.WF2, MROWS, 1024, FFD, FFD}; pg8::StaticOrder S; S.init(MROWS, 1024, F.G, (int)blockIdx.x);
        pg8::EpiResid E{F.out + OUT_Y, F.out + OUT_Y + (size_t)MCTX * 1024, F.out + OUT_Y, (rep > 0 || dummy) ? (const float*)(ws + WS_CTL + 256 * 1024) : F.MOD + 5120};
        pg8::gemm_phase<pg8::EpiResid, pg8::StaticOrder, PG8_ALIGN, PG8_SP2>(F.lds + RING_OFF, g, S, E);
        if (BOTH(10)) GRID_BAR();
    }
    if (IN(11)) { for (int rep = MK_REP11 - 1; rep >= 0; --rep) { p11_final(F, (rep > 0 || dummy) ? (float*)(ws + WS_HB) : F.out + OUT_Y); if (rep > 0) GRID_BAR(); } }
#undef IN
#undef BOTH
#undef GRID_BAR
}

extern "C" void kernel_launch(void* const* d_in, const int* in_sizes, int n_in, void* d_out, int out_size, void* d_ws, size_t ws_size, hipStream_t stream) {
    static int grid = 0;
    if (grid == 0) {
        if (n_in != 22 || out_size != (int)OUT_TOTAL || ws_size < WS_END) { fprintf(stderr, "kernel_launch: unexpected shapes: n_in %d out %d ws %zu; nothing launched\n", n_in, out_size, ws_size); grid = -1; return; }
        int dev = 0, cus = 0, per_cu = 0;
        if (hipGetDevice(&dev) != hipSuccess || hipDeviceGetAttribute(&cus, hipDeviceAttributeMultiprocessorCount, dev) != hipSuccess) { fprintf(stderr, "kernel_launch: device query failed\n"); grid = -1; return; }
        if (hipFuncSetAttribute((const void*)mk_fwd, hipFuncAttributeMaxDynamicSharedMemorySize, LDS_BYTES) != hipSuccess) { fprintf(stderr, "kernel_launch: hipFuncSetAttribute failed\n"); grid = -1; return; }
        if (hipOccupancyMaxActiveBlocksPerMultiprocessor(&per_cu, (const void*)mk_fwd, NWAVES * 64, LDS_BYTES) != hipSuccess || per_cu < 1) { fprintf(stderr, "kernel_launch: occupancy query reports %d workgroups per CU\n", per_cu); (void)hipGetLastError(); grid = -1; return; }
        grid = cus;
        if (grid > 256) grid = 256;
    }
    if (grid < 0) return;
    static const int seq[][3] = MK_SEQ;
    for (int li = 0; li < (int)(sizeof(seq) / sizeof(seq[0])); ++li) {
        if (hipMemsetAsync((char*)d_ws + WS_CTL, 0, li == 0 ? CTL_ZERO_BYTES : 64 * 1024, stream) != hipSuccess) { fprintf(stderr, "kernel_launch: hipMemsetAsync failed\n"); return; }
        Args a{};
        for (int i = 0; i < 22; ++i) a.in[i] = (const float*)d_in[i];
        a.out = (float*)d_out; a.ws = (unsigned char*)d_ws; a.ph_lo = seq[li][0]; a.ph_hi = seq[li][1]; a.flags = seq[li][2];
        hipLaunchKernelGGL(mk_fwd, dim3(grid), dim3(NWAVES * 64), LDS_BYTES, stream, a);
        const hipError_t le = hipPeekAtLastError();
        if (le != hipSuccess) { fprintf(stderr, "kernel_launch: launch %d failed: %s\n", li, hipGetErrorName(le)); break; }
    }
}
```
